# Optimizing an MI355X kernel written in HIP

```python
import math
import jax, jax.numpy as jnp
from jax import lax
import numpy as np

D_MODEL = 2048
BATCH = 1
SEQ = 16384
DEPTH = 2

MIX_WIDTH = D_MODEL
DIFF_HEADS = 8
DIFF_DIM = 64
DIFF_WIDTH = DIFF_HEADS * 2 * DIFF_DIM
DIL_HEADS = 8
DIL_DIM = 128
DIL_WIDTH = DIL_HEADS * DIL_DIM
DIL_BRANCHES = ((128, 1), (512, 4), (2048, 16))
QKV_WIDTH = 3 * DIFF_WIDTH + 3 * DIL_WIDTH
ROPE_THETA = 10000.0
Q_BLOCK = 128
D_FF = 5632
N_EXPERTS = 8
TOP_K = 2
D_EXPERT = 7168
MOE_BLOCK = 256
EPS = 1e-6
NEG = -1e30

kernel_name = "hymba_diffattn_dilated_moe_encoder"


def rms_norm(x, g):
    xf = x.astype(jnp.float32)
    y = xf * lax.rsqrt(jnp.mean(xf * xf, axis=-1, keepdims=True) + EPS)
    return (y * g.astype(jnp.float32)).astype(x.dtype)


def rope_tables(seq, dim):
    pos = jnp.arange(seq, dtype=jnp.float32)
    inv = ROPE_THETA ** (-jnp.arange(0, dim, 2, dtype=jnp.float32) / dim)
    ang = pos[:, None] * inv[None, :]
    ang = jnp.concatenate([ang, ang], axis=-1)
    return jnp.cos(ang), jnp.sin(ang)


def apply_rope(x, cos, sin):
    xf = x.astype(jnp.float32)
    x1, x2 = jnp.split(xf, 2, axis=-1)
    rot = jnp.concatenate([-x2, x1], axis=-1)
    return (xf * cos + rot * sin).astype(x.dtype)


def diff_attention(q, k, v, lam, lam_init, q_g, k_g, o_g, cos, sin):
    c, s_ = cos[:, None, None, :], sin[:, None, None, :]
    q = apply_rope(rms_norm(q, q_g), c, s_) * (DIFF_DIM ** -0.5)
    k = apply_rope(rms_norm(k, k_g), c, s_)
    q = q.transpose(0, 2, 3, 1, 4)
    k = k.transpose(0, 2, 3, 1, 4)
    v = v.transpose(0, 2, 1, 3)
    B, H, _, S, Dd = q.shape
    nq = S // Q_BLOCK
    qb = jnp.moveaxis(q.reshape(B, H, 2, nq, Q_BLOCK, Dd), 3, 0)

    def block(qi):
        sc = jnp.einsum('bhmqd,bhmkd->bhmqk', qi, k).astype(jnp.float32)
        p = jax.nn.softmax(sc, axis=-1)
        a = p[:, :, 0] - lam * p[:, :, 1]
        return jnp.einsum('bhqk,bhkd->bhqd', a.astype(v.dtype), v)

    o = lax.map(block, qb)
    o = jnp.moveaxis(o, 0, 2).reshape(B, H, S, 2 * Dd)
    o = rms_norm(o, o_g) * (1.0 - lam_init)
    return o.transpose(0, 2, 1, 3).reshape(B, S, H * 2 * Dd)


def dilated_branch(q, k, v, window, dil):
    n_side = window // (2 * dil)
    blk = n_side
    B, H, S, D = q.shape
    L = S // dil
    nb = -(-L // blk)
    Lp = nb * blk

    def strided(t):
        return t.reshape(B, H, L, dil, D).transpose(0, 1, 3, 2, 4)

    qs = jnp.pad(strided(q), ((0, 0), (0, 0), (0, 0), (0, Lp - L), (0, 0)))
    ks = jnp.pad(strided(k), ((0, 0), (0, 0), (0, 0), (blk, Lp - L + blk), (0, 0)))
    vs = jnp.pad(strided(v), ((0, 0), (0, 0), (0, 0), (blk, Lp - L + blk), (0, 0)))
    qb = qs.reshape(B, H, dil, nb, blk, D)
    kidx = jnp.arange(nb)[:, None] * blk + jnp.arange(3 * blk)[None, :]
    kb = ks[:, :, :, kidx, :]
    vb = vs[:, :, :, kidx, :]
    m_pos = jnp.arange(nb)[:, None] * blk + jnp.arange(blk)[None, :]
    n_pos = kidx - blk
    valid = ((n_pos[:, None, :] >= 0) & (n_pos[:, None, :] < L)
             & (jnp.abs(m_pos[:, :, None] - n_pos[:, None, :]) <= n_side))
    sc = jnp.einsum('bhrnqd,bhrnkd->bhrnqk', qb, kb).astype(jnp.float32)
    sc = jnp.where(valid, sc, NEG)
    mx = jnp.max(sc, axis=-1, keepdims=True)
    p = jnp.exp(sc - mx)
    den = jnp.sum(p, axis=-1, keepdims=True)
    o = jnp.einsum('bhrnqk,bhrnkd->bhrnqd', (p / den).astype(v.dtype), vb)
    lse = (mx + jnp.log(den))[..., 0]
    o = o.reshape(B, H, dil, Lp, D)[:, :, :, :L].transpose(0, 1, 3, 2, 4).reshape(B, H, S, D)
    lse = lse.reshape(B, H, dil, Lp)[..., :L].transpose(0, 1, 3, 2).reshape(B, H, S)
    return o, lse


def dilated_attention(q, k, v, q_g, k_g, o_g, cos, sin):
    c, s_ = cos[:, None, :], sin[:, None, :]
    q = apply_rope(rms_norm(q, q_g), c, s_) * (DIL_DIM ** -0.5)
    k = apply_rope(rms_norm(k, k_g), c, s_)
    q, k, v = (t.transpose(0, 2, 1, 3) for t in (q, k, v))
    outs, lses = [], []
    for window, dil in DIL_BRANCHES:
        o, l = dilated_branch(q, k, v, window, dil)
        outs.append(o)
        lses.append(l)
    w = jax.nn.softmax(jnp.stack(lses), axis=0)
    o = jnp.einsum('gbhs,gbhsd->bhsd', w.astype(v.dtype), jnp.stack(outs))
    o = rms_norm(o, o_g)
    B, H, S, D = o.shape
    return o.transpose(0, 2, 1, 3).reshape(B, S, H * D)


def dense_swiglu(h, wg, wu, wd):
    return (jax.nn.silu(h @ wg) * (h @ wu)) @ wd


def moe_swiglu(h, router, wg, wu, wd):
    B, S, D = h.shape
    T = B * S
    xt = h.reshape(T, D)
    logits = xt.astype(jnp.float32) @ router.astype(jnp.float32)
    top_val, top_idx = lax.top_k(logits, TOP_K)
    gates = jax.nn.softmax(top_val, axis=-1)
    n_assign = T * TOP_K
    e_flat = top_idx.reshape(-1).astype(jnp.int32)
    tok_flat = jnp.repeat(jnp.arange(T, dtype=jnp.int32), TOP_K)
    g_flat = gates.reshape(-1)
    order = jnp.argsort(e_flat)
    e_s, tok_s, g_s = e_flat[order], tok_flat[order], g_flat[order]
    counts = jnp.bincount(e_flat, length=N_EXPERTS)
    starts = jnp.cumsum(counts) - counts
    nblk_e = (counts + MOE_BLOCK - 1) // MOE_BLOCK
    cum_blk = jnp.cumsum(nblk_e)
    pad_starts = (cum_blk - nblk_e) * MOE_BLOCK
    pos = pad_starts[e_s] + jnp.arange(n_assign, dtype=jnp.int32) - starts[e_s]
    n_blocks = -(-n_assign // MOE_BLOCK) + N_EXPERTS
    tok_buf = jnp.full((n_blocks * MOE_BLOCK,), T, jnp.int32).at[pos].set(tok_s)
    g_buf = jnp.zeros((n_blocks * MOE_BLOCK,), jnp.float32).at[pos].set(g_s)
    blk_expert = jnp.minimum(jnp.searchsorted(cum_blk, jnp.arange(n_blocks), side='right'),
                             N_EXPERTS - 1)
    x_pad = jnp.concatenate([xt, jnp.zeros((1, D), xt.dtype)], axis=0)

    def run(args):
        tok, e = args
        xb = x_pad[tok]
        return (jax.nn.silu(xb @ wg[e]) * (xb @ wu[e])) @ wd[e]

    ys = lax.map(run, (tok_buf.reshape(n_blocks, MOE_BLOCK), blk_expert))
    y = jnp.zeros((T + 1, D), h.dtype).at[tok_buf].add(
        ys.reshape(-1, D) * g_buf[:, None].astype(h.dtype))
    return y[:T].reshape(B, S, D)


def setup_inputs(seed: int = 0) -> dict:
    key = jax.random.key(seed)
    keys = iter(jax.random.split(key, 64))

    def nrm(shape, scale):
        return jax.random.normal(next(keys), shape, jnp.float32) * scale

    def gain(n):
        return 1.0 + nrm((n,), 0.02)

    d = {"x": nrm((BATCH, SEQ, D_MODEL), 1.0)}
    for i in range(DEPTH):
        d[f"attn_norm_{i}"] = gain(D_MODEL)
        d[f"w_in_{i}"] = nrm((D_MODEL, QKV_WIDTH), D_MODEL ** -0.5)
        d[f"diff_q_norm_{i}"] = gain(DIFF_DIM)
        d[f"diff_k_norm_{i}"] = gain(DIFF_DIM)
        d[f"diff_lam_q1_{i}"] = nrm((DIFF_DIM,), 0.1)
        d[f"diff_lam_k1_{i}"] = nrm((DIFF_DIM,), 0.1)
        d[f"diff_lam_q2_{i}"] = nrm((DIFF_DIM,), 0.1)
        d[f"diff_lam_k2_{i}"] = nrm((DIFF_DIM,), 0.1)
        d[f"diff_out_norm_{i}"] = gain(2 * DIFF_DIM)
        d[f"dil_q_norm_{i}"] = gain(DIL_DIM)
        d[f"dil_k_norm_{i}"] = gain(DIL_DIM)
        d[f"dil_out_norm_{i}"] = gain(DIL_DIM)
        d[f"w_out_{i}"] = nrm((MIX_WIDTH, D_MODEL), MIX_WIDTH ** -0.5)
        d[f"ffn_norm_{i}"] = gain(D_MODEL)
        if i % 2 == 0:
            d[f"ffn_w_gate_{i}"] = nrm((D_MODEL, D_FF), D_MODEL ** -0.5)
            d[f"ffn_w_up_{i}"] = nrm((D_MODEL, D_FF), D_MODEL ** -0.5)
            d[f"ffn_w_down_{i}"] = nrm((D_FF, D_MODEL), D_FF ** -0.5)
        else:
            d[f"router_{i}"] = nrm((D_MODEL, N_EXPERTS), D_MODEL ** -0.5)
            d[f"moe_w_gate_{i}"] = nrm((N_EXPERTS, D_MODEL, D_EXPERT), D_MODEL ** -0.5)
            d[f"moe_w_up_{i}"] = nrm((N_EXPERTS, D_MODEL, D_EXPERT), D_MODEL ** -0.5)
            d[f"moe_w_down_{i}"] = nrm((N_EXPERTS, D_EXPERT, D_MODEL), D_EXPERT ** -0.5)
    return d


def reference(x,
              attn_norm_0, w_in_0, diff_q_norm_0, diff_k_norm_0, diff_lam_q1_0, diff_lam_k1_0,
              diff_lam_q2_0, diff_lam_k2_0, diff_out_norm_0, dil_q_norm_0, dil_k_norm_0,
              dil_out_norm_0, w_out_0, ffn_norm_0, ffn_w_gate_0, ffn_w_up_0, ffn_w_down_0,
              attn_norm_1, w_in_1, diff_q_norm_1, diff_k_norm_1, diff_lam_q1_1, diff_lam_k1_1,
              diff_lam_q2_1, diff_lam_k2_1, diff_out_norm_1, dil_q_norm_1, dil_k_norm_1,
              dil_out_norm_1, w_out_1, ffn_norm_1, router_1, moe_w_gate_1, moe_w_up_1,
              moe_w_down_1):
    mix_params = [
        (attn_norm_0, w_in_0, diff_q_norm_0, diff_k_norm_0, diff_lam_q1_0, diff_lam_k1_0,
         diff_lam_q2_0, diff_lam_k2_0, diff_out_norm_0, dil_q_norm_0, dil_k_norm_0,
         dil_out_norm_0, w_out_0, ffn_norm_0),
        (attn_norm_1, w_in_1, diff_q_norm_1, diff_k_norm_1, diff_lam_q1_1, diff_lam_k1_1,
         diff_lam_q2_1, diff_lam_k2_1, diff_out_norm_1, dil_q_norm_1, dil_k_norm_1,
         dil_out_norm_1, w_out_1, ffn_norm_1),
    ]
    ffn_params = [(ffn_w_gate_0, ffn_w_up_0, ffn_w_down_0),
                  (router_1, moe_w_gate_1, moe_w_up_1, moe_w_down_1)]
    B, S, _ = x.shape
    cos_a, sin_a = rope_tables(S, DIFF_DIM)
    cos_b, sin_b = rope_tables(S, DIL_DIM)
    split_at = [int(v) for v in np.cumsum([DIFF_WIDTH] * 3 + [DIL_WIDTH] * 3)[:-1]]
    for i in range(DEPTH):
        (a_norm, w_in, dqn, dkn, lq1, lk1, lq2, lk2, don, bqn, bkn, bon, w_out,
         f_norm) = mix_params[i]
        lam_init = 0.8 - 0.6 * math.exp(-0.3 * i)
        lam = (jnp.exp(jnp.sum(lq1.astype(jnp.float32) * lk1.astype(jnp.float32)))
               - jnp.exp(jnp.sum(lq2.astype(jnp.float32) * lk2.astype(jnp.float32)))
               + lam_init)
        h = rms_norm(x, a_norm)
        proj = h @ w_in
        qa, ka, va, qb, kb, vb = jnp.split(proj, split_at, axis=-1)
        out_a = diff_attention(qa.reshape(B, S, DIFF_HEADS, 2, DIFF_DIM),
                               ka.reshape(B, S, DIFF_HEADS, 2, DIFF_DIM),
                               va.reshape(B, S, DIFF_HEADS, 2 * DIFF_DIM),
                               lam, lam_init, dqn, dkn, don, cos_a, sin_a)
        out_b = dilated_attention(qb.reshape(B, S, DIL_HEADS, DIL_DIM),
                                  kb.reshape(B, S, DIL_HEADS, DIL_DIM),
                                  vb.reshape(B, S, DIL_HEADS, DIL_DIM),
                                  bqn, bkn, bon, cos_b, sin_b)
        x = x + jnp.concatenate([out_a, out_b], axis=-1) @ w_out
        h = rms_norm(x, f_norm)
        if i % 2 == 0:
            x = x + dense_swiglu(h, *ffn_params[i])
        else:
            x = x + moe_swiglu(h, *ffn_params[i])
    return x
```

```cpp
#include <hip/hip_runtime.h>
#include <cstdio>
#include <cstdint>

#ifndef MK_PER_PHASE
#define MK_PER_PHASE 0
#endif

#define LAS __attribute__((address_space(3)))
#define GAS __attribute__((address_space(1)))
typedef unsigned short bf16;
typedef short bf16x8 __attribute__((ext_vector_type(8)));
typedef short s16x4 __attribute__((ext_vector_type(4)));
typedef float f32x4 __attribute__((ext_vector_type(4)));
typedef float f32x2 __attribute__((ext_vector_type(2)));
typedef float f32x16 __attribute__((ext_vector_type(16)));
typedef unsigned u32x4 __attribute__((ext_vector_type(4)));
typedef unsigned u32x2 __attribute__((ext_vector_type(2)));

constexpr int S = 16384, DM = 2048, QKVW = 6144, DFF = 5632, NE = 8, DEXP = 7168;
constexpr int MPAD_MAX = 2 * S + NE * 256;
constexpr float EPS = 1e-6f;
constexpr float LOG2E = 1.4426950408889634f;

constexpr size_t MiB = 1u << 20;
constexpr size_t WS_CTL = 0, CTL_ZERO_BYTES = 1 * MiB;
constexpr size_t WS_WIN = 2 * MiB;
constexpr size_t WS_WOUT = 50 * MiB;
constexpr size_t WS_WGU = 66 * MiB;
constexpr size_t WS_WDN = 110 * MiB;
constexpr size_t WS_MGU = 132 * MiB;
constexpr size_t WS_MDN = 580 * MiB;
constexpr size_t WS_H = 804 * MiB;
constexpr size_t WS_AO = 868 * MiB;
constexpr size_t WS_ROPE = 932 * MiB;
constexpr size_t WS_TOK = 944 * MiB;
constexpr size_t WS_XG = 946 * MiB;
constexpr size_t WS_YE = 1082 * MiB;
constexpr size_t WS_BIG = 1218 * MiB;
constexpr size_t WS_QKV = WS_BIG, WS_DILP = WS_BIG + 192 * MiB, WS_DILL = WS_DILP + 192 * MiB, WS_HID = WS_BIG;
constexpr size_t WS_END = WS_BIG + 476 * MiB;
constexpr size_t TK_E = 0, TK_G = (size_t)S * 2 * 4, TK_POS = (size_t)S * 4 * 4, TK_WGCNT = (size_t)S * 6 * 4, TK_META = TK_WGCNT + 256 * 8 * 4;
constexpr int CW_BAR = 4096;

__device__ __forceinline__ unsigned f2bf(float f) { unsigned u = __builtin_bit_cast(unsigned, f); return (u + 0x7fffu + ((u >> 16) & 1u)) >> 16; }
__device__ __forceinline__ unsigned pk2(float lo, float hi) { return f2bf(lo) | (f2bf(hi) << 16); }
__device__ __forceinline__ float bf2f(unsigned short b) { return __builtin_bit_cast(float, ((unsigned)b) << 16); }
__device__ __forceinline__ float bflo(unsigned w) { return __builtin_bit_cast(float, w << 16); }
__device__ __forceinline__ float bfhi(unsigned w) { return __builtin_bit_cast(float, w & 0xffff0000u); }
__device__ __forceinline__ unsigned cvtpk(float lo, float hi) { unsigned r; asm volatile("v_cvt_pk_bf16_f32 %0, %1, %2" : "=v"(r) : "v"(lo), "v"(hi)); return r; }
#define LDS_WAIT() asm volatile("s_waitcnt lgkmcnt(0)" ::: "memory")
#define VM_WAIT() asm volatile("s_waitcnt vmcnt(0)" ::: "memory")
#define SBAR() __builtin_amdgcn_sched_barrier(0)
__device__ __forceinline__ float wave_sum(float v) {
#pragma unroll
    for (int o = 1; o < 64; o <<= 1) v += __shfl_xor(v, o);
    return v;
}
namespace pg8 {
#define PG8_LAS __attribute__((address_space(3)))
typedef unsigned short bf16_t;
typedef short bf16x8 __attribute__((ext_vector_type(8)));
typedef float f32x4 __attribute__((ext_vector_type(4)));
typedef unsigned u32x4 __attribute__((ext_vector_type(4)));
constexpr int BM = 256, BK = 64, HALF = 128, HTB = HALF * BK * 2  , STAGE_BYTES = 8 * HTB, NXCD = 8, WGM = 8;

__host__ __device__ __forceinline__ int lds_byte(int r, int c) { const int st = (r >> 4) * 2 + (c >> 5), rr = r & 15, cc = c & 31, ob = rr * 64 + cc * 2; return st * 1024 + (ob ^ (((ob >> 9) & 1) << 5)); }
__host__ __device__ __forceinline__ void stage_rc(int b, int& R, int& C) { const int st = b / 1024, sb = b % 1024, swz = sb ^ (((sb >> 9) & 1) << 5); R = (st >> 1) * 16 + swz / 64; C = (st & 1) * 32 + (swz % 64) / 2; }
__host__ __device__ __forceinline__ int perm32(int rho) { const int n = rho >> 4, i = rho & 15; return 8 * (i >> 2) + 4 * n + (i & 3); }

struct Unit { int pm, pn; };
struct Gemm { const bf16_t* A; const bf16_t* Bt; int M, N, K; };

struct StaticOrder {
    int nM, nN, nwg, G, c;
    __host__ __device__ void init(int M, int N, int G_, int c_) { nM = M / BM; nN = N / BM; nwg = nM * nN; G = G_; c = c_; }
    __host__ __device__ bool next(int i, Unit& u) const {
        const long L = (long)i * G + c; if (L >= nwg) return false;
        int wgid = (int)L; { const int q = nwg / NXCD, r = nwg % NXCD, xcd = wgid % NXCD, off = wgid / NXCD; wgid = (xcd < r ? xcd * (q + 1) : r * (q + 1) + (xcd - r) * q) + off; }
        const int nig = WGM * nN, gid = wgid / nig, fm = gid * WGM, gsz = (nM - fm) < WGM ? (nM - fm) : WGM;
        u.pm = fm + ((wgid % nig) % gsz); u.pn = (wgid % nig) / gsz; return true;
    }
    __device__ __forceinline__ void a_ready(const Unit&) const {}
    __device__ __forceinline__ void done(const Unit&) const {}
};

struct MoeOrder {
    int ts0, ts1, ts2, ts3, ts4, ts5, ts6, ts7, ts8; int NT, nwg, G, c;
    __device__ void init(const int* tstart, int NT_, int G_, int c_) { ts0 = tstart[0]; ts1 = tstart[1]; ts2 = tstart[2]; ts3 = tstart[3]; ts4 = tstart[4]; ts5 = tstart[5]; ts6 = tstart[6]; ts7 = tstart[7]; ts8 = tstart[8];
        NT = NT_; nwg = ts8 * NT_; G = G_; c = c_; }
    __device__ bool next(int i, Unit& u) const {
        const long L = (long)i * G + c; if (L >= nwg) return false;
        int wgid = (int)L; { const int q = nwg / NXCD, r = nwg % NXCD, xcd = wgid % NXCD, off = wgid / NXCD; wgid = (xcd < r ? xcd * (q + 1) : r * (q + 1) + (xcd - r) * q) + off; }
        const int t = wgid / NT;
        int e = 0, lo = ts0, hi = ts1;
        if (t >= ts1) { e = 1; lo = ts1; hi = ts2; } if (t >= ts2) { e = 2; lo = ts2; hi = ts3; } if (t >= ts3) { e = 3; lo = ts3; hi = ts4; } if (t >= ts4) { e = 4; lo = ts4; hi = ts5; }
        if (t >= ts5) { e = 5; lo = ts5; hi = ts6; } if (t >= ts6) { e = 6; lo = ts6; hi = ts7; } if (t >= ts7) { e = 7; lo = ts7; hi = ts8; }
        const int Te = hi - lo, local = wgid - lo * NT;
        u.pm = lo + local % Te; u.pn = e * NT + local / Te; return true;
    }
    __device__ __forceinline__ void a_ready(const Unit&) const {}
    __device__ __forceinline__ void done(const Unit&) const {}
};

__device__ __forceinline__ unsigned cvt_pk_bf16(float lo, float hi) { unsigned r; asm volatile("v_cvt_pk_bf16_f32 %0, %1, %2" : "=v"(r) : "v"(lo), "v"(hi)); return r; }

struct EpiBf16 {
    static constexpr bool PERM = true, AFTER_DRAIN = false;
    bf16_t* O; int ldc; int ntn;
    __device__ __forceinline__ void operator()(const f32x4 (&acc)[2][2][4][2], const Unit& u, int wr, int wc, int fr, int fq) const {
        const int row0 = u.pm * BM + wr * 64 + fr; const int colt = (u.pn % ntn) * BM;
        const int col0 = colt + wc * 32 + 8 * fq;
#pragma unroll
        for (int ai = 0; ai < 2; ++ai)
#pragma unroll
            for (int m = 0; m < 4; ++m) { bf16_t* rowp = O + (size_t)(row0 + ai * HALF + m * 16) * ldc + col0;
#pragma unroll
                for (int bj = 0; bj < 2; ++bj) { const f32x4 v0 = acc[ai][bj][m][0], v1 = acc[ai][bj][m][1];
                    u32x4 w; w.x = cvt_pk_bf16(v0[0], v0[1]); w.y = cvt_pk_bf16(v0[2], v0[3]); w.z = cvt_pk_bf16(v1[0], v1[1]); w.w = cvt_pk_bf16(v1[2], v1[3]);
                    *(u32x4*)(rowp + bj * HALF) = w; } }
    }
};
struct EpiRes {
    static constexpr bool PERM = false, AFTER_DRAIN = false;
    float* C; const float* R; int ldc;
    __device__ __forceinline__ void operator()(const f32x4 (&acc)[2][2][4][2], const Unit& u, int wr, int wc, int fr, int fq) const {
        const int row0 = u.pm * BM + wr * 64 + fr, col0 = u.pn * BM + wc * 32 + 4 * fq;
#pragma unroll
        for (int ai = 0; ai < 2; ++ai)
#pragma unroll
            for (int m = 0; m < 4; ++m) { const size_t off = (size_t)(row0 + ai * HALF + m * 16) * ldc + col0;
                f32x4 rv[2][2];
#pragma unroll
                for (int bj = 0; bj < 2; ++bj)
#pragma unroll
                    for (int n = 0; n < 2; ++n) rv[bj][n] = *(const f32x4*)(R + off + bj * HALF + n * 16);
#pragma unroll
                for (int bj = 0; bj < 2; ++bj)
#pragma unroll
                    for (int n = 0; n < 2; ++n) *(f32x4*)(C + off + bj * HALF + n * 16) = acc[ai][bj][m][n] + rv[bj][n]; }
    }
};
__device__ __forceinline__ float silu_mul(float g, float u) { return g * u * __builtin_amdgcn_rcpf(1.0f + __builtin_amdgcn_exp2f(-1.4426950408889634f * g)); }
struct EpiSwiGLU {
    static constexpr bool PERM = true, AFTER_DRAIN = false;
    bf16_t* O; int ldh; int ntn;
    __device__ __forceinline__ void operator()(const f32x4 (&acc)[2][2][4][2], const Unit& u, int wr, int wc, int fr, int fq) const {
        const int row0 = u.pm * BM + wr * 64 + fr; const int col0 = (u.pn % ntn) * HALF + wc * 32 + 8 * fq;
#pragma unroll
        for (int ai = 0; ai < 2; ++ai)
#pragma unroll
            for (int m = 0; m < 4; ++m) { bf16_t* rowp = O + (size_t)(row0 + ai * HALF + m * 16) * ldh + col0;
                const f32x4 g0 = acc[ai][0][m][0], g1 = acc[ai][0][m][1], u0 = acc[ai][1][m][0], u1 = acc[ai][1][m][1];
                u32x4 w; w.x = cvt_pk_bf16(silu_mul(g0[0], u0[0]), silu_mul(g0[1], u0[1])); w.y = cvt_pk_bf16(silu_mul(g0[2], u0[2]), silu_mul(g0[3], u0[3]));
                w.z = cvt_pk_bf16(silu_mul(g1[0], u1[0]), silu_mul(g1[1], u1[1])); w.w = cvt_pk_bf16(silu_mul(g1[2], u1[2]), silu_mul(g1[3], u1[3]));
                *(u32x4*)rowp = w; }
    }
};

template <class Epi, class Sched, bool STAMP = false>
__device__ __forceinline__ void gemm_phase(PG8_LAS unsigned char* lds, const Gemm g, const Sched& S, const Epi& E, unsigned long long* stamps) {
    int tid = threadIdx.x; asm volatile("" : "+v"(tid));
    const int wid = __builtin_amdgcn_readfirstlane(tid >> 6), lane = tid & 63, wr = wid >> 2, wc = wid & 3, fr = lane & 15, fq = lane >> 4;
    const int K = g.K, nt = K / BK;
    int ts_lo = 0, ts_hi = 0, nts = 0; const unsigned long long rt_entry = STAMP ? (unsigned long long)wall_clock64() : 0ull;
#define PG8_STAMP() do { if (STAMP && wid == 0 && nts < 64) { const unsigned long long _c = (unsigned long long)clock64(); \
        ts_lo = (lane == nts) ? (int)(unsigned)_c : ts_lo; ts_hi = (lane == nts) ? (int)(unsigned)(_c >> 32) : ts_hi; ++nts; } } while (0)
    PG8_STAMP();
    unsigned voffA[2], voffB[2];
#pragma unroll
    for (int i = 0; i < 2; ++i) { int R, C; stage_rc(tid * 16 + i * 8192, R, C); const int Rb = Epi::PERM ? ((R & ~31) + perm32(R & 31)) : R;
        voffA[i] = (unsigned)(R * K + C) * 2u; voffB[i] = (unsigned)(Rb * K + C) * 2u; }
    const size_t kstep = (size_t)(BK * 2);
    const size_t hstep = (size_t)HALF * K * 2;
    const size_t tstep = 2 * hstep;
    const unsigned ldsw = (unsigned)wid * 1024u;
    const int aoff = lds_byte(wr * 64 + fr, fq * 8), boff = lds_byte(wc * 32 + fr, fq * 8);
#define PG8_SA(b, h) (((b) * 2 + (h)) * HTB)
#define PG8_SB(b, h) ((4 + (b) * 2 + (h)) * HTB)
#define PG8_STAGE(bufoff, gbase, voff) do { _Pragma("unroll") for (int _i = 0; _i < 2; ++_i) \
        __builtin_amdgcn_global_load_lds((const unsigned*)((const char*)(gbase) + (voff)[_i]), (PG8_LAS unsigned*)(lds + (bufoff) + ldsw + _i * 8192), 16, 0, 0); } while (0)
#define PG8_LDA(dst, b, h) do { _Pragma("unroll") for (int m = 0; m < 4; ++m) _Pragma("unroll") for (int k = 0; k < 2; ++k) dst[m][k] = *(const PG8_LAS bf16x8*)(lds + PG8_SA(b, h) + aoff + m * 2048 + k * 1024); } while (0)
#define PG8_LDB(dst, b, h) do { _Pragma("unroll") for (int n = 0; n < 2; ++n) _Pragma("unroll") for (int k = 0; k < 2; ++k) dst[n][k] = *(const PG8_LAS bf16x8*)(lds + PG8_SB(b, h) + boff + n * 2048 + k * 1024); } while (0)
#define PG8_MMA(ai, bj, At, Bt) do { __builtin_amdgcn_s_setprio(1); _Pragma("unroll") for (int m = 0; m < 4; ++m) _Pragma("unroll") for (int n = 0; n < 2; ++n) _Pragma("unroll") for (int k = 0; k < 2; ++k) \
        acc[ai][bj][m][n] = __builtin_amdgcn_mfma_f32_16x16x32_bf16(Bt[n][k], At[m][k], acc[ai][bj][m][n], 0, 0, 0); __builtin_amdgcn_s_setprio(0); } while (0)
#define PG8_WAIT_V(n) asm volatile("s_waitcnt vmcnt(" #n ")" ::: "memory")
#define PG8_WAIT_L(n) asm volatile("s_waitcnt lgkmcnt(" #n ")" ::: "memory")
#define PG8_BAR __builtin_amdgcn_s_barrier()
#define PG8_SCHED __builtin_amdgcn_sched_barrier(0)
    Unit cur, nxt; int ui = 0;
    if (!S.next(0, cur)) return;
    f32x4 acc[2][2][4][2];
#pragma unroll
    for (int a = 0; a < 2; ++a)
#pragma unroll
        for (int b = 0; b < 2; ++b)
#pragma unroll
            for (int m = 0; m < 4; ++m)
#pragma unroll
                for (int n = 0; n < 2; ++n) acc[a][b][m][n] = (f32x4){0.f, 0.f, 0.f, 0.f};
    bf16x8 At[4][2], B0[2][2], B1[2][2];
    const char* cA = (const char*)g.A + (size_t)cur.pm * tstep; const char* cB = (const char*)g.Bt + (size_t)cur.pn * tstep;
    S.a_ready(cur);
    PG8_STAGE(PG8_SB(0, 0), cB, voffB); PG8_STAGE(PG8_SA(0, 0), cA, voffA); PG8_STAGE(PG8_SB(0, 1), cB + hstep, voffB); PG8_STAGE(PG8_SA(0, 1), cA + hstep, voffA);
    if (wr == 1) PG8_BAR;
    PG8_WAIT_V(4); PG8_BAR;
    PG8_STAGE(PG8_SB(1, 0), cB + kstep, voffB); PG8_STAGE(PG8_SA(1, 0), cA + kstep, voffA); PG8_STAGE(PG8_SB(1, 1), cB + hstep + kstep, voffB);
    PG8_WAIT_V(6); PG8_BAR;
    PG8_STAMP();
    for (;;) {
        const bool has_next = S.next(ui + 1, nxt);
        const char* nA = has_next ? (const char*)g.A + (size_t)nxt.pm * tstep : cA; const char* nB = has_next ? (const char*)g.Bt + (size_t)nxt.pn * tstep : cB;
        for (int t = 0; t < nt; t += 2) {
            const bool last = (t == nt - 2);
            const char* a1 = cA + (size_t)(t + 1) * kstep;
            const char* a2 = last ? nA : cA + (size_t)(t + 2) * kstep; const char* b2 = last ? nB : cB + (size_t)(t + 2) * kstep;
            const char* a3 = a2 + kstep; const char* b3 = b2 + kstep;
            if (last && has_next) S.a_ready(nxt);
            PG8_LDB(B0, 0, 0); PG8_SCHED; PG8_LDA(At, 0, 0); PG8_STAGE(PG8_SA(1, 1), a1 + hstep, voffA);
            PG8_WAIT_L(8); PG8_BAR; PG8_WAIT_L(0); PG8_MMA(0, 0, At, B0); PG8_BAR; PG8_SCHED;
            PG8_LDB(B1, 0, 1); PG8_STAGE(PG8_SB(0, 0), b2, voffB);
            PG8_BAR; PG8_WAIT_L(0); PG8_MMA(0, 1, At, B1); PG8_BAR;
            PG8_LDA(At, 0, 1); PG8_STAGE(PG8_SA(0, 0), a2, voffA);
            PG8_BAR; PG8_WAIT_L(0); PG8_MMA(1, 0, At, B0); PG8_BAR; PG8_SCHED;
            PG8_STAGE(PG8_SB(0, 1), b2 + hstep, voffB);
            PG8_WAIT_V(6); PG8_BAR; PG8_MMA(1, 1, At, B1); PG8_BAR;
            PG8_LDB(B0, 1, 0); PG8_SCHED; PG8_LDA(At, 1, 0); PG8_STAGE(PG8_SA(0, 1), a2 + hstep, voffA);
            PG8_WAIT_L(8); PG8_BAR; PG8_WAIT_L(0); PG8_MMA(0, 0, At, B0); PG8_BAR; PG8_SCHED;
            PG8_LDB(B1, 1, 1); PG8_STAGE(PG8_SB(1, 0), b3, voffB);
            PG8_BAR; PG8_WAIT_L(0); PG8_MMA(0, 1, At, B1); PG8_BAR;
            PG8_LDA(At, 1, 1); PG8_STAGE(PG8_SA(1, 0), a3, voffA);
            PG8_BAR; PG8_WAIT_L(0); PG8_MMA(1, 0, At, B0); PG8_BAR; PG8_SCHED;
            PG8_STAGE(PG8_SB(1, 1), b3 + hstep, voffB);
            PG8_WAIT_V(6); PG8_BAR; PG8_MMA(1, 1, At, B1); PG8_BAR;
        }
        PG8_STAMP();
        if constexpr (!Epi::AFTER_DRAIN) { E(acc, cur, wr, wc, fr, fq); S.done(cur); }
        PG8_STAMP();
        if (!has_next) break;
#pragma unroll
        for (int a = 0; a < 2; ++a)
#pragma unroll
            for (int b = 0; b < 2; ++b)
#pragma unroll
                for (int m = 0; m < 4; ++m)
#pragma unroll
                    for (int n = 0; n < 2; ++n) acc[a][b][m][n] = (f32x4){0.f, 0.f, 0.f, 0.f};
        cur = nxt; cA = nA; cB = nB; ++ui;
    }
    PG8_WAIT_V(0);
    if (wr == 0) PG8_BAR;
    PG8_BAR;
    if constexpr (Epi::AFTER_DRAIN) { E.fused(acc, cur, wr, wc, fr, fq, lds, wid, lane); S.done(cur); }
    PG8_STAMP();
    if (STAMP && wid == 0) { stamps[lane] = lane < nts ? (((unsigned long long)(unsigned)ts_hi << 32) | (unsigned)ts_lo) : 0ull;
        if (lane == 62) stamps[62] = rt_entry; if (lane == 63) stamps[63] = (unsigned long long)wall_clock64(); }
#undef PG8_STAMP
#undef PG8_SA
#undef PG8_SB
#undef PG8_STAGE
#undef PG8_LDA
#undef PG8_LDB
#undef PG8_MMA
#undef PG8_WAIT_V
#undef PG8_WAIT_L
#undef PG8_BAR
#undef PG8_SCHED
}
}
#define XB_TMO      128
#define XB_XCNT(j)  (256  + 64 * (j))
#define XB_XSUB(j)  (1280 + 64 * (j))
#define XB_XGEN(j)  (2304 + 64 * (j))
#define XB_TOP      3328
#define XB_TOPGEN   3392
#define XCD_BAR_WORDS 3456
#define XB_SPIN_CAP (1u << 21)

__device__ __forceinline__ unsigned xb_ld(unsigned* p)              { return __hip_atomic_load(p, __ATOMIC_RELAXED, __HIP_MEMORY_SCOPE_AGENT); }
__device__ __forceinline__ unsigned xb_add(unsigned* p, unsigned v) { return __hip_atomic_fetch_add(p, v, __ATOMIC_RELAXED, __HIP_MEMORY_SCOPE_AGENT); }
__device__ __forceinline__ unsigned xb_xcc_id() { return (unsigned)__builtin_amdgcn_s_getreg((3 << 11) | 20) & 0xFu; }
#define XB_SPIN(cond, bar) do { unsigned _sp = 0; while (cond) { __builtin_amdgcn_s_sleep(1); \
    if ((++_sp & 255u) == 0u) { if (xb_ld(&(bar)[XB_TMO])) break; if (_sp > XB_SPIN_CAP) { atomicAdd(&(bar)[XB_TMO], 1u); break; } } } } while (0)

struct XcdBarrier {
    unsigned* bar; unsigned x;
    volatile LAS unsigned* st;
};

__device__ __forceinline__ XcdBarrier xcd_barrier_post(unsigned* bar, volatile LAS unsigned* st) {
    XcdBarrier b; b.bar = bar; b.x = xb_xcc_id(); b.st = st;
    if (threadIdx.x == 0) (void)xb_add(&bar[XB_XCNT(b.x)], 1u);
    return b;
}
__device__ __forceinline__ void xcd_barrier_complete(unsigned* bar, unsigned x, unsigned& nloc, unsigned& nx) {
    const unsigned G = gridDim.x * gridDim.y * gridDim.z;
    unsigned sum, cnt, mine, sp = 0u;
    for (;;) {
        sum = 0u; cnt = 0u; mine = 0u;
#pragma unroll
        for (unsigned j = 0; j < 16; ++j) { const unsigned c = xb_ld(&bar[XB_XCNT(j)]); sum += c; cnt += (c > 0u) ? 1u : 0u; mine = (j == x) ? c : mine; }
        if (sum == G) break;
        __builtin_amdgcn_s_sleep(1);
        if ((++sp & 255u) == 0u) { if (xb_ld(&bar[XB_TMO])) break; if (sp > XB_SPIN_CAP) { atomicAdd(&bar[XB_TMO], 1u); break; } }
    }
    nloc = mine > 0u ? mine : 1u; nx = cnt > 0u ? cnt : 1u;
}

__device__ __forceinline__ void xcd_barrier(const XcdBarrier& b) {
    asm volatile("s_waitcnt vmcnt(0)" ::: "memory");
    __syncthreads();
    if (threadIdx.x == 0) {
        unsigned* bar = b.bar;
        __builtin_amdgcn_s_waitcnt(0);
        unsigned nloc = b.st[0], nx = b.st[1];
        if (nloc == 0u) { xcd_barrier_complete(bar, b.x, nloc, nx); b.st[0] = nloc; b.st[1] = nx; }
        const unsigned old = xb_add(&bar[XB_XSUB(b.x)], 1u);
        const unsigned gen = old / nloc;
        if (old + 1u == (gen + 1u) * nloc) {
            __builtin_amdgcn_fence(__ATOMIC_RELEASE, "agent");
            asm volatile("s_waitcnt vmcnt(0)" ::: "memory");
            const unsigned og = xb_add(&bar[XB_TOP], 1u);
            const unsigned tg = og / nx;
            if (og + 1u == (tg + 1u) * nx) xb_add(&bar[XB_TOPGEN], 1u);
            else XB_SPIN(xb_ld(&bar[XB_TOPGEN]) == tg, bar);
            __builtin_amdgcn_fence(__ATOMIC_ACQUIRE, "agent");
            xb_add(&bar[XB_XGEN(b.x)], 1u);
            asm volatile("s_waitcnt vmcnt(0)" ::: "memory");
        } else {
            XB_SPIN(xb_ld(&bar[XB_XGEN(b.x)]) == gen, bar);
            __builtin_amdgcn_fence(__ATOMIC_ACQUIRE, "agent");
            asm volatile("s_waitcnt vmcnt(0)" ::: "memory");
        }
    }
    __syncthreads();
}

constexpr int NWAVES = 8, NTHR = 512;
constexpr int RING_BYTES = 131072;
constexpr int MISC_OFF = RING_BYTES;
constexpr int LDS_BYTES = 147456;

struct Frame {
    unsigned char* lds;
    int tid, lane, wave, G, c;
    const float* const* in;
    float* out; unsigned char* ws;
};

template <bool GU>
__device__ __forceinline__ void tr_item(const float* __restrict__ W, int K, int N, bf16* __restrict__ WT, int upoff, float* scr, int item, int lane) {
    const int nblk = N / 32, kb = item / nblk, nb = item % nblk, k0 = 64 * kb, n0 = 32 * nb;
    float v[32];
#pragma unroll
    for (int i = 0; i < 32; ++i) { const int kk = 2 * i + (lane >> 5); v[i] = W[(size_t)(k0 + kk) * N + n0 + (lane & 31)]; }
#pragma unroll
    for (int i = 0; i < 32; ++i) { const int kk = 2 * i + (lane >> 5); scr[kk * 33 + (lane & 31)] = v[i]; }
    LDS_WAIT(); asm volatile("" ::: "memory");
    const int c = lane & 7;
#pragma unroll
    for (int j = 0; j < 4; ++j) { const int n = (lane >> 3) + 8 * j; const float* s = scr + (8 * c) * 33 + n;
        u32x4 o; o.x = pk2(s[0 * 33], s[1 * 33]); o.y = pk2(s[2 * 33], s[3 * 33]); o.z = pk2(s[4 * 33], s[5 * 33]); o.w = pk2(s[6 * 33], s[7 * 33]);
        const int np = n0 + n; const int orow = GU ? (((np >> 7) << 8) + (np & 127) + upoff) : np;
        *(u32x4*)(WT + (size_t)orow * K + k0 + 8 * c) = o; }
    LDS_WAIT(); asm volatile("" ::: "memory");
}

__device__ __forceinline__ void rms_row(const float* __restrict__ xrow, const float* __restrict__ g, bf16* __restrict__ orow, int lane, f32x4 (&v)[8]) {
    const f32x4* xr = (const f32x4*)xrow + lane; float s = 0.f;
#pragma unroll
    for (int j = 0; j < 8; ++j) { v[j] = xr[64 * j]; s += (v[j].x * v[j].x + v[j].y * v[j].y) + (v[j].z * v[j].z + v[j].w * v[j].w); }
    const float rstd = 1.0f / sqrtf(wave_sum(s) * (1.f / DM) + EPS);
    const f32x4* gr = (const f32x4*)g + lane;
    unsigned long long* o8 = (unsigned long long*)orow + lane;
#pragma unroll
    for (int j = 0; j < 8; ++j) { const f32x4 gg = gr[64 * j]; v[j] = v[j] * rstd * gg;
        o8[64 * j] = (unsigned long long)pk2(v[j].x, v[j].y) | ((unsigned long long)pk2(v[j].z, v[j].w) << 32); }
}

__device__ __forceinline__ void norm_phase(Frame& F, const float* X, const float* g, bf16* H) {
    const int gw = F.c * NWAVES + F.wave, NGW = F.G * NWAVES;
    for (int m = gw; m < S; m += NGW) { f32x4 v[8]; rms_row(X + (size_t)m * DM, g, H + (size_t)m * DM, F.lane, v); }
}

__device__ __forceinline__ void p0_prologue(Frame& F) {
    float* scr = (float*)(F.lds + F.wave * 16384);
    const int gw = F.c * NWAVES + F.wave, NGW = F.G * NWAVES;
    unsigned char* ws = F.ws;
    constexpr int I_IN = (DM / 64) * (QKVW / 32), I_OUT = (DM / 64) * (DM / 32), I_GU = (DM / 64) * (DFF / 32), I_DN = (DFF / 64) * (DM / 32);
    constexpr int I_MGU = (DM / 64) * (DEXP / 32), I_MDN = (DEXP / 64) * (DM / 32);
    constexpr int NSMALL = 2 * I_IN + 2 * I_OUT + 2 * I_GU + I_DN;
    for (int it = gw; it < NSMALL; it += NGW) {
        int r = it;
        if (r < 2 * I_IN) { const int l = r / I_IN; r -= l * I_IN; tr_item<false>(F.in[2 + 17 * l], DM, QKVW, (bf16*)(ws + WS_WIN) + (size_t)l * QKVW * DM, 0, scr, r, F.lane); continue; } r -= 2 * I_IN;
        if (r < 2 * I_OUT) { const int l = r / I_OUT; r -= l * I_OUT; tr_item<false>(F.in[13 + 17 * l], DM, DM, (bf16*)(ws + WS_WOUT) + (size_t)l * DM * DM, 0, scr, r, F.lane); continue; } r -= 2 * I_OUT;
        if (r < 2 * I_GU) { const int up = r / I_GU; r -= up * I_GU; tr_item<true>(F.in[15 + up], DM, DFF, (bf16*)(ws + WS_WGU), up * 128, scr, r, F.lane); continue; } r -= 2 * I_GU;
        tr_item<false>(F.in[17], DFF, DM, (bf16*)(ws + WS_WDN), 0, scr, r, F.lane);
    }
    for (int it = gw; it < 2 * NE * I_MGU; it += NGW) {
        const int up = it / (NE * I_MGU); int r = it - up * (NE * I_MGU); const int e = r / I_MGU; r -= e * I_MGU;
        tr_item<true>(F.in[33 + up] + (size_t)e * DM * DEXP, DM, DEXP, (bf16*)(ws + WS_MGU) + (size_t)e * 2 * DEXP * DM, up * 128, scr, r, F.lane);
    }
    for (int it = gw; it < NE * I_MDN; it += NGW) {
        const int e = it / I_MDN; const int r = it - e * I_MDN;
        tr_item<false>(F.in[35] + (size_t)e * DEXP * DM, DEXP, DM, (bf16*)(ws + WS_MDN) + (size_t)e * DM * DEXP, 0, scr, r, F.lane);
    }
    {
        float* cosA = (float*)(ws + WS_ROPE); float* sinA = cosA + (size_t)S * 32; float* cosB = sinA + (size_t)S * 32; float* sinB = cosB + (size_t)S * 64;
        const int gt = F.c * NTHR + F.tid, NGT = F.G * NTHR;
        for (int idx = gt; idx < S * 96; idx += NGT) {
            const int pos = idx / 96, j = idx % 96; const bool isA = j < 32; const int i = isA ? j : j - 32;
            const double r = isA ? 0.7498942093324559 : 0.8659643233600653;
            double inv = 1.0; for (int q = 0; q < i; ++q) inv *= r;
            double t = (double)pos * inv * 0.15915494309189535; t -= __builtin_rint(t);
            const float tf = (float)t; const float sn = __builtin_amdgcn_sinf(tf), cs = __builtin_amdgcn_cosf(tf);
            if (isA) { cosA[(size_t)pos * 32 + i] = cs; sinA[(size_t)pos * 32 + i] = sn; } else { cosB[(size_t)pos * 64 + i] = cs; sinB[(size_t)pos * 64 + i] = sn; }
        }
    }
    norm_phase(F, F.in[0], F.in[1], (bf16*)(ws + WS_H));
}

template <int GRP>
__device__ __forceinline__ void qknorm_rope_seg(bf16* seg, const float* __restrict__ gain, const float* __restrict__ ct, const float* __restrict__ st, float qscale, int lane) {
    constexpr int DIMS = GRP * 16, HALFD = DIMS / 2;
    u32x4 w0 = *(const u32x4*)(seg + 16 * lane), w1 = *(const u32x4*)(seg + 16 * lane + 8);
    float x[16];
    x[0] = bflo(w0.x); x[1] = bfhi(w0.x); x[2] = bflo(w0.y); x[3] = bfhi(w0.y); x[4] = bflo(w0.z); x[5] = bfhi(w0.z); x[6] = bflo(w0.w); x[7] = bfhi(w0.w);
    x[8] = bflo(w1.x); x[9] = bfhi(w1.x); x[10] = bflo(w1.y); x[11] = bfhi(w1.y); x[12] = bflo(w1.z); x[13] = bfhi(w1.z); x[14] = bflo(w1.w); x[15] = bfhi(w1.w);
    float ss = 0.f;
#pragma unroll
    for (int e = 0; e < 16; ++e) ss += x[e] * x[e];
#pragma unroll
    for (int o = 1; o < GRP; o <<= 1) ss += __shfl_xor(ss, o);
    const float rstd = 1.0f / sqrtf(ss * (1.f / DIMS) + EPS);
    const int j0 = 16 * (lane & (GRP - 1));
    const int jj0 = j0 & (HALFD - 1);
    const bool first = j0 < HALFD;
    float y[16], o[16];
#pragma unroll
    for (int e = 0; e < 16; ++e) y[e] = x[e] * rstd * gain[j0 + e];
#pragma unroll
    for (int e = 0; e < 16; ++e) { const float p = __shfl_xor(y[e], GRP / 2); const float cs = ct[jj0 + e], sn = st[jj0 + e];
        o[e] = (y[e] * cs + (first ? -p : p) * sn) * qscale; }
    u32x4 r0, r1;
    r0.x = pk2(o[0], o[1]); r0.y = pk2(o[2], o[3]); r0.z = pk2(o[4], o[5]); r0.w = pk2(o[6], o[7]);
    r1.x = pk2(o[8], o[9]); r1.y = pk2(o[10], o[11]); r1.z = pk2(o[12], o[13]); r1.w = pk2(o[14], o[15]);
    *(u32x4*)(seg + 16 * lane) = r0; *(u32x4*)(seg + 16 * lane + 8) = r1;
}
__device__ __forceinline__ void qknorm_rope_phase(Frame& F, int l) {
    const int gw = F.c * NWAVES + F.wave, NGW = F.G * NWAVES;
    bf16* QKV = (bf16*)(F.ws + WS_QKV);
    const float* cosA = (const float*)(F.ws + WS_ROPE); const float* sinA = cosA + (size_t)S * 32; const float* cosB = sinA + (size_t)S * 32; const float* sinB = cosB + (size_t)S * 64;
    const float* dqn = F.in[1 + 17 * l + 2]; const float* dkn = F.in[1 + 17 * l + 3]; const float* bqn = F.in[1 + 17 * l + 9]; const float* bkn = F.in[1 + 17 * l + 10];
    for (int m = gw; m < S; m += NGW) {
        bf16* row = QKV + (size_t)m * QKVW;
        qknorm_rope_seg<4>(row, dqn, cosA + (size_t)m * 32, sinA + (size_t)m * 32, 0.125f * LOG2E, F.lane);
        qknorm_rope_seg<4>(row + 1024, dkn, cosA + (size_t)m * 32, sinA + (size_t)m * 32, 1.0f, F.lane);
        qknorm_rope_seg<8>(row + 3072, bqn, cosB + (size_t)m * 64, sinB + (size_t)m * 64, 0.08838834764831845f * LOG2E, F.lane);
        qknorm_rope_seg<8>(row + 4096, bkn, cosB + (size_t)m * 64, sinB + (size_t)m * 64, 1.0f, F.lane);
    }
}

__device__ __forceinline__ void dil_combine_phase(Frame& F, int l) {
    const int gw = F.c * NWAVES + F.wave, NGW = F.G * NWAVES, lane = F.lane;
    const float* OP = (const float*)(F.ws + WS_DILP); const float* LP = (const float*)(F.ws + WS_DILL);
    bf16* AO = (bf16*)(F.ws + WS_AO); const float* bon = F.in[1 + 17 * l + 11];
    const int head = lane >> 3, cb = (16 * lane) & 127;
    for (int m = gw; m < S; m += NGW) {
        f32x4 a[4]; float ls = 0.f;
#pragma unroll
        for (int q = 0; q < 4; ++q) a[q] = (f32x4){0.f, 0.f, 0.f, 0.f};
#pragma unroll
        for (int b = 0; b < 3; ++b) { const f32x4* p = (const f32x4*)(OP + ((size_t)b * S + m) * 1024 + 16 * lane);
#pragma unroll
            for (int q = 0; q < 4; ++q) a[q] += p[q];
            ls += LP[((size_t)b * S + m) * 8 + head]; }
        const float il = 1.0f / ls; float ss = 0.f;
#pragma unroll
        for (int q = 0; q < 4; ++q) { a[q] = a[q] * il; ss += (a[q].x * a[q].x + a[q].y * a[q].y) + (a[q].z * a[q].z + a[q].w * a[q].w); }
        ss += __shfl_xor(ss, 1); ss += __shfl_xor(ss, 2); ss += __shfl_xor(ss, 4);
        const float rstd = 1.0f / sqrtf(ss * (1.f / 128.f) + EPS);
        u32x4 r0, r1; const f32x4* gp = (const f32x4*)(bon + cb);
        f32x4 g0 = gp[0], g1 = gp[1], g2 = gp[2], g3 = gp[3];
        a[0] = a[0] * rstd * g0; a[1] = a[1] * rstd * g1; a[2] = a[2] * rstd * g2; a[3] = a[3] * rstd * g3;
        r0.x = pk2(a[0].x, a[0].y); r0.y = pk2(a[0].z, a[0].w); r0.z = pk2(a[1].x, a[1].y); r0.w = pk2(a[1].z, a[1].w);
        r1.x = pk2(a[2].x, a[2].y); r1.y = pk2(a[2].z, a[2].w); r1.z = pk2(a[3].x, a[3].y); r1.w = pk2(a[3].z, a[3].w);
        bf16* o = AO + (size_t)m * DM + 1024 + 16 * lane;
        *(u32x4*)o = r0; *(u32x4*)(o + 8) = r1;
    }
}

__device__ __forceinline__ void norm_router_phase(Frame& F, const float* X, const float* g, bf16* H, const float* router) {
    float* Rt = (float*)F.lds;
    int* cnt = (int*)(F.lds + 65536);
    for (int idx = F.tid; idx < DM * NE; idx += NTHR) { const int j = idx >> 3, e = idx & 7; Rt[e * DM + j] = router[idx]; }
    if (F.tid < 8) cnt[F.tid] = 0;
    __syncthreads();
    int* TKE = (int*)(F.ws + WS_TOK + TK_E); float* TKG = (float*)(F.ws + WS_TOK + TK_G);
    const int lane = F.lane;
    for (int i = 0; i < 8; ++i) {
        const int m = 64 * F.c + 8 * F.wave + i;
        f32x4 v[8]; rms_row(X + (size_t)m * DM, g, H + (size_t)m * DM, lane, v);
        float lg[8];
#pragma unroll
        for (int e = 0; e < 8; ++e) { float a = 0.f;
#pragma unroll
            for (int j = 0; j < 8; ++j) { const f32x4 r = *(const f32x4*)(Rt + e * DM + 256 * j + 4 * lane); a += (v[j].x * r.x + v[j].y * r.y) + (v[j].z * r.z + v[j].w * r.w); }
            lg[e] = wave_sum(a); }
        int e0 = 0; float v0 = lg[0];
#pragma unroll
        for (int e = 1; e < 8; ++e) if (lg[e] > v0) { v0 = lg[e]; e0 = e; }
        int e1 = -1; float v1 = -3.0e38f;
#pragma unroll
        for (int e = 0; e < 8; ++e) if (e != e0 && lg[e] > v1) { v1 = lg[e]; e1 = e; }
        const float g0 = 1.0f / (1.0f + __expf(v1 - v0)), g1 = 1.0f - g0;
        if (lane == 0) { TKE[2 * m] = e0; TKE[2 * m + 1] = e1; TKG[2 * m] = g0; TKG[2 * m + 1] = g1; atomicAdd(&cnt[e0], 1); atomicAdd(&cnt[e1], 1); }
    }
    __syncthreads();
    if (F.tid < 8) ((int*)(F.ws + WS_TOK + TK_WGCNT))[F.c * 8 + F.tid] = cnt[F.tid];
    __syncthreads();
}

__device__ __forceinline__ void moe_scatter_phase(Frame& F) {
    int* call = (int*)F.lds;
    int* tot = call + 2048; int* before = tot + 8; int* base = before + 8; int* pstart = base + 8; int* rowmap = pstart + 16;
    const int* WGC = (const int*)(F.ws + WS_TOK + TK_WGCNT);
    for (int idx = F.tid; idx < 2048; idx += NTHR) call[idx] = WGC[idx];
    __syncthreads();
    if (F.tid < 8) { int t = 0, b = 0; for (int w = 0; w < 256; ++w) { const int x = call[w * 8 + F.tid]; if (w < F.c) b += x; t += x; } tot[F.tid] = t; before[F.tid] = b; }
    __syncthreads();
    if (F.tid == 0) { int ps = 0; for (int e = 0; e < 8; ++e) { pstart[e] = ps; base[e] = ps + before[e]; ps += ((tot[e] + 255) >> 8) << 8; } pstart[8] = ps;
        if (F.c == 0) { int* meta = (int*)(F.ws + WS_TOK + TK_META); for (int e = 0; e <= 8; ++e) meta[e] = pstart[e] >> 8; } }
    __syncthreads();
    const int* TKE = (const int*)(F.ws + WS_TOK + TK_E); int* TKP = (int*)(F.ws + WS_TOK + TK_POS);
    if (F.tid < 8) { int rk = base[F.tid]; for (int a = 0; a < 128; ++a) { const int tokslot = 64 * F.c * 2 + a; if (TKE[tokslot] == F.tid) { rowmap[a] = rk; TKP[tokslot] = rk; ++rk; } } }
    __syncthreads();
    const bf16* H = (const bf16*)(F.ws + WS_H); bf16* XG = (bf16*)(F.ws + WS_XG);
    for (int a = F.wave * 16; a < F.wave * 16 + 16; ++a) {
        const int tok = 64 * F.c + (a >> 1), pos = rowmap[a];
        const u32x4* src = (const u32x4*)(H + (size_t)tok * DM) + F.lane; u32x4* dst = (u32x4*)(XG + (size_t)pos * DM) + F.lane;
#pragma unroll
        for (int q = 0; q < 4; ++q) dst[64 * q] = src[64 * q];
    }
    for (int e = 0; e < 8; ++e) { const int r0 = pstart[e] + tot[e], r1 = pstart[e + 1];
        for (int r = r0 + F.wave; r < r1; r += NWAVES) if (((r & 255) % F.G) == F.c % 256) { u32x4* dst = (u32x4*)(XG + (size_t)r * DM) + F.lane;
#pragma unroll
            for (int q = 0; q < 4; ++q) dst[64 * q] = (u32x4){0u, 0u, 0u, 0u}; } }
    __syncthreads();
}

__device__ __forceinline__ void moe_combine_phase(Frame& F) {
    const int gw = F.c * NWAVES + F.wave, NGW = F.G * NWAVES, lane = F.lane;
    const float* TKG = (const float*)(F.ws + WS_TOK + TK_G); const int* TKP = (const int*)(F.ws + WS_TOK + TK_POS);
    const bf16* YE = (const bf16*)(F.ws + WS_YE);
    for (int m = gw; m < S; m += NGW) {
        const float g0 = TKG[2 * m], g1 = TKG[2 * m + 1]; const int p0 = TKP[2 * m], p1 = TKP[2 * m + 1];
        f32x4* xr = (f32x4*)(F.out + (size_t)m * DM) + lane;
        const u32x2* y0 = (const u32x2*)(YE + (size_t)p0 * DM) + lane; const u32x2* y1 = (const u32x2*)(YE + (size_t)p1 * DM) + lane;
#pragma unroll
        for (int j = 0; j < 8; ++j) { f32x4 x = xr[64 * j]; const u32x2 a = y0[64 * j], b = y1[64 * j];
            x.x += g0 * bflo(a.x) + g1 * bflo(b.x); x.y += g0 * bfhi(a.x) + g1 * bfhi(b.x); x.z += g0 * bflo(a.y) + g1 * bflo(b.y); x.w += g0 * bfhi(a.y) + g1 * bfhi(b.y);
            xr[64 * j] = x; }
    }
}
#ifndef ATT_SDEPTH
#define ATT_SDEPTH 1
#endif
constexpr int SDEPTH = ATT_SDEPTH;
constexpr size_t SHM_V = 64 * 128 * 2, SHM_K = 64 * 128 * 2;
#define KSWZ(row, colB) ((row) * 256 + ((colB) ^ (((row) & 7) << 4)))
__device__ __forceinline__ int crow(int r, int hi) { return (r & 3) + 8 * (r >> 2) + 4 * hi; }
__device__ __forceinline__ int v_st(int k, int c) { const int kk = (k & ~0xC) | ((k & 4) << 1) | ((k & 8) >> 1); return ((kk >> 3) * 4 + (c >> 5)) * 512 + ((kk & 7) * 32 + (c & 31)) * 2; }
__device__ __forceinline__ int v_rd_base(int lane) { return ((lane & 3) << 3) | (((lane >> 2) & 3) << 6) | (((lane >> 4) & 1) << 5) | (((lane >> 5) & 1) << 8); }
constexpr int v_rd_off(int d0, int ks, int half) { return d0 * 512 + ks * 4096 + half * 2048; }
template <int OFF> __device__ __forceinline__ s16x4 tr_read(int vb) {
    s16x4 r; asm volatile("ds_read_b64_tr_b16 %0, %1 offset:%2" : "=&v"(r) : "v"(vb), "i"(OFF) : "memory"); return r;
}
template <int D0> __device__ __forceinline__ void pv_one(f32x16& od, int vb, bf16x8 pa0, bf16x8 pa1, bf16x8 pa2, bf16x8 pa3) {
    const s16x4 l0 = tr_read<v_rd_off(D0, 0, 0)>(vb), h0 = tr_read<v_rd_off(D0, 0, 1)>(vb), l1 = tr_read<v_rd_off(D0, 1, 0)>(vb), h1 = tr_read<v_rd_off(D0, 1, 1)>(vb);
    const s16x4 l2 = tr_read<v_rd_off(D0, 2, 0)>(vb), h2 = tr_read<v_rd_off(D0, 2, 1)>(vb), l3 = tr_read<v_rd_off(D0, 3, 0)>(vb), h3 = tr_read<v_rd_off(D0, 3, 1)>(vb);
    asm volatile("s_waitcnt lgkmcnt(0)" ::: "memory"); SBAR();
#define PK(L, H) (bf16x8){L[0], L[1], L[2], L[3], H[0], H[1], H[2], H[3]}
    od = __builtin_amdgcn_mfma_f32_32x32x16_bf16(pa0, PK(l0, h0), od, 0, 0, 0);
    od = __builtin_amdgcn_mfma_f32_32x32x16_bf16(pa1, PK(l1, h1), od, 0, 0, 0);
    od = __builtin_amdgcn_mfma_f32_32x32x16_bf16(pa2, PK(l2, h2), od, 0, 0, 0);
    od = __builtin_amdgcn_mfma_f32_32x32x16_bf16(pa3, PK(l3, h3), od, 0, 0, 0);
#undef PK
}
__device__ __forceinline__ void pv_d0(f32x16 (&o)[4], int vb, bf16x8 pa0, bf16x8 pa1, bf16x8 pa2, bf16x8 pa3) {
    pv_one<0>(o[0], vb, pa0, pa1, pa2, pa3); pv_one<1>(o[1], vb, pa0, pa1, pa2, pa3); pv_one<2>(o[2], vb, pa0, pa1, pa2, pa3); pv_one<3>(o[3], vb, pa0, pa1, pa2, pa3);
}
template <int NQ>
__device__ __forceinline__ void qkt(f32x16& p0, f32x16& p1, const char* Ks, const bf16x8 (&qr)[NQ], int r32, int hi, int kd0, float negb) {
#pragma unroll
    for (int r = 0; r < 16; ++r) { p0[r] = negb; p1[r] = negb; }
#pragma unroll
    for (int d0 = 0; d0 < NQ; ++d0) { const int cb = (kd0 + d0 * 16 + hi * 8) * 2;
        const bf16x8 b0 = *reinterpret_cast<const bf16x8*>(Ks + KSWZ(r32, cb));
        const bf16x8 b1 = *reinterpret_cast<const bf16x8*>(Ks + KSWZ(32 + r32, cb));
        p0 = __builtin_amdgcn_mfma_f32_32x32x16_bf16(b0, qr[d0], p0, 0, 0, 0);
        p1 = __builtin_amdgcn_mfma_f32_32x32x16_bf16(b1, qr[d0], p1, 0, 0, 0); }
}
template <bool DIL>
__device__ __forceinline__ void sm_half(f32x16& p, int dbase, int mq, int L) {
#pragma unroll
    for (int r = 0; r < 16; ++r) { const float e = __builtin_amdgcn_exp2f(p[r]);
        if (DIL) { const int delta = dbase + (r & 3) + 8 * (r >> 2); const bool ok = ((unsigned)(delta + 64) <= 128u) && ((unsigned)(mq + delta) < (unsigned)L); p[r] = ok ? e : 0.f; }
        else p[r] = e; }
}
__device__ __forceinline__ void finish_sm(const f32x16& p0, const f32x16& p1, float& l_reg, bf16x8& pa0, bf16x8& pa1, bf16x8& pa2, bf16x8& pa3) {
    float ps = 0;
#pragma unroll
    for (int r = 0; r < 16; ++r) ps += p0[r];
#pragma unroll
    for (int r = 0; r < 16; ++r) ps += p1[r];
    { auto rr = __builtin_amdgcn_permlane32_swap(__float_as_uint(ps), __float_as_uint(ps), false, false);
      ps = __uint_as_float(rr[0]) + __uint_as_float(rr[1]); }
    l_reg += ps;
#define PK4(P, BASE, OUT) do { unsigned a0 = cvtpk(P[BASE + 0], P[BASE + 1]), a1 = cvtpk(P[BASE + 2], P[BASE + 3]);   \
    unsigned b0 = cvtpk(P[BASE + 4], P[BASE + 5]), b1 = cvtpk(P[BASE + 6], P[BASE + 7]);                              \
    auto r0 = __builtin_amdgcn_permlane32_swap(a0, b0, false, false); auto r1 = __builtin_amdgcn_permlane32_swap(a1, b1, false, false); \
    u32x4 w = {r0[0], r1[0], r0[1], r1[1]}; OUT = *reinterpret_cast<bf16x8*>(&w); } while (0)
    PK4(p0, 0, pa0); PK4(p0, 8, pa1); PK4(p1, 0, pa2); PK4(p1, 8, pa3);
#undef PK4
}

template <int NQ, bool DIL>
__device__ __forceinline__ void attn_core(const bf16* __restrict__ QKV, int dil, int res, int L, int mq0, int mk0, int NT, int kcol, int vcol, int kd0, float negb,
                                          const bf16x8 (&qr)[NQ], char* lds, f32x16 (&o)[4], float& l_reg) {
    int tid = threadIdx.x; asm volatile("" : "+v"(tid));
    const int lane = tid & 63, r32 = lane & 31, hi = lane >> 5;
    char* V_lds = lds; char* K_lds = lds + 2 * SHM_V;
    const int sr = tid >> 4, sc = (tid & 15) * 8, vst0 = v_st(sr, sc), vst1 = v_st(32 + sr, sc);
    const int vb0 = (int)(uintptr_t)V_lds + v_rd_base(lane);
    const int mq = mq0 + r32;
    struct { bf16x8 vs0, vs1, ks0, ks1; } sr_[SDEPTH];
#define ROWP(t, kk) ({ int mk_ = mk0 + 64 * (t) + (kk); if (DIL) mk_ = mk_ < 0 ? 0 : (mk_ > L - 1 ? L - 1 : mk_); QKV + ((size_t)mk_ * dil + res) * QKVW + sc; })
#define SLOAD(i, t) do { const bf16* ra_ = ROWP(t, sr); const bf16* rb_ = ROWP(t, 32 + sr); \
    sr_[i].vs0 = *(const bf16x8*)(ra_ + vcol); sr_[i].vs1 = *(const bf16x8*)(rb_ + vcol); sr_[i].ks0 = *(const bf16x8*)(ra_ + kcol); sr_[i].ks1 = *(const bf16x8*)(rb_ + kcol); } while (0)
#define SWRITE(b, i) do { *(bf16x8*)(V_lds + (b) * SHM_V + vst0) = sr_[i].vs0; *(bf16x8*)(V_lds + (b) * SHM_V + vst1) = sr_[i].vs1; const int kc_ = sc * 2; \
    *(bf16x8*)(K_lds + (b) * SHM_K + KSWZ(sr, kc_)) = sr_[i].ks0; *(bf16x8*)(K_lds + (b) * SHM_K + KSWZ(32 + sr, kc_)) = sr_[i].ks1; } while (0)
#define SWAIT() do { if (SDEPTH == 2) asm volatile("s_waitcnt vmcnt(4)" ::: "memory"); else asm volatile("s_waitcnt vmcnt(0)" ::: "memory"); } while (0)
#define DB0(t) (mk0 + 64 * (t) + 4 * hi - mq)
    f32x16 pA0, pA1, pB0, pB1; bf16x8 pa0, pa1, pa2, pa3;
    constexpr int SE = 0, SO = SDEPTH - 1;
    SLOAD(SE, 0); asm volatile("s_waitcnt vmcnt(0)" ::: "memory"); SWRITE(0, SE); __syncthreads();
    qkt<NQ>(pA0, pA1, K_lds, qr, r32, hi, kd0, negb); sm_half<DIL>(pA0, DB0(0), mq, L);
    SLOAD(SO, 1); if (SDEPTH == 2 && 2 < NT) SLOAD(SE, 2);
    SWAIT(); SWRITE(1, SO); __syncthreads();
    for (int j = 1; j + 1 < NT; j += 2) {
        SBAR(); qkt<NQ>(pB0, pB1, K_lds + SHM_K, qr, r32, hi, kd0, negb);
        sm_half<DIL>(pA1, DB0(j - 1) + 32, mq, L); finish_sm(pA0, pA1, l_reg, pa0, pa1, pa2, pa3); SBAR();
        SLOAD(SO, j + SDEPTH); SBAR();
        pv_d0(o, vb0, pa0, pa1, pa2, pa3); sm_half<DIL>(pB0, DB0(j), mq, L);
        __syncthreads(); SWAIT(); SWRITE(0, SE);
        __syncthreads();
        SBAR(); qkt<NQ>(pA0, pA1, K_lds, qr, r32, hi, kd0, negb);
        sm_half<DIL>(pB1, DB0(j) + 32, mq, L); finish_sm(pB0, pB1, l_reg, pa0, pa1, pa2, pa3); SBAR();
        if (SDEPTH == 1 || j + 3 < NT) SLOAD(SE, j + 1 + SDEPTH); SBAR();
        pv_d0(o, vb0 + (int)SHM_V, pa0, pa1, pa2, pa3); sm_half<DIL>(pA0, DB0(j + 1), mq, L);
        __syncthreads(); SWAIT(); SWRITE(1, SO);
        __syncthreads();
    }
    SBAR(); qkt<NQ>(pB0, pB1, K_lds + SHM_K, qr, r32, hi, kd0, negb);
    sm_half<DIL>(pA1, DB0(NT - 2) + 32, mq, L); finish_sm(pA0, pA1, l_reg, pa0, pa1, pa2, pa3); SBAR();
    pv_d0(o, vb0, pa0, pa1, pa2, pa3); sm_half<DIL>(pB0, DB0(NT - 1), mq, L);
    sm_half<DIL>(pB1, DB0(NT - 1) + 32, mq, L); finish_sm(pB0, pB1, l_reg, pa0, pa1, pa2, pa3); SBAR();
    pv_d0(o, vb0 + (int)SHM_V, pa0, pa1, pa2, pa3);
    __syncthreads();
#undef ROWP
#undef SLOAD
#undef SWRITE
#undef SWAIT
#undef DB0
}

__device__ __forceinline__ void diff_unit(Frame& F, int h, int qb, float lam, float oscale, float negb, const float* __restrict__ og) {
    const bf16* QKV = (const bf16*)(F.ws + WS_QKV); bf16* AO = (bf16*)(F.ws + WS_AO);
    { unsigned z_; asm volatile("s_mov_b32 %0, 0" : "=s"(z_)); QKV += z_; AO += z_; }
    int lane = F.lane; asm volatile("" : "+v"(lane));
    const int r32 = lane & 31, hi = lane >> 5, map = F.wave >> 2, wq = F.wave & 3;
    const int mq0 = qb * 128 + wq * 32;
    bf16x8 qr[4];
    { const bf16* Qw = QKV + (size_t)(mq0 + r32) * QKVW + h * 128 + map * 64 + hi * 8;
#pragma unroll
      for (int d0 = 0; d0 < 4; ++d0) qr[d0] = *(const bf16x8*)(Qw + d0 * 16); }
    f32x16 o[4];
#pragma unroll
    for (int d = 0; d < 4; ++d)
#pragma unroll
        for (int r = 0; r < 16; ++r) o[d][r] = 0.f;
    float l_reg = 0.f;
    char* lds = (char*)F.lds;
    attn_core<4, false>(QKV, 1, 0, S, mq0, 0, S / 64, 1024 + h * 128, 2048 + h * 128, map * 64, negb, qr, lds, o, l_reg);
    float* li_l = (float*)(lds + 65536) + F.wave * 64;
    if (hi == 0) li_l[r32] = l_reg;
    LDS_WAIT();
    float* xch = (float*)lds;
#pragma unroll
    for (int r = 0; r < 16; ++r) { const float rl = __builtin_amdgcn_rcpf(li_l[crow(r, hi)]);
#pragma unroll
        for (int d = 0; d < 4; ++d) o[d][r] *= rl; }
    if (map == 1) {
#pragma unroll
        for (int d = 0; d < 4; ++d)
#pragma unroll
            for (int r = 0; r < 16; ++r) xch[(d * 16 + r) * 256 + wq * 64 + lane] = o[d][r];
    }
    __syncthreads();
    if (map == 0) {
        float gv[4];
#pragma unroll
        for (int d = 0; d < 4; ++d) gv[d] = og[32 * d + r32] * oscale;
#pragma unroll
        for (int r = 0; r < 16; ++r) {
            float ss = 0.f;
#pragma unroll
            for (int d = 0; d < 4; ++d) { const float v = o[d][r] - lam * xch[(d * 16 + r) * 256 + wq * 64 + lane]; o[d][r] = v; ss += v * v; }
            ss += __shfl_xor(ss, 1); ss += __shfl_xor(ss, 2); ss += __shfl_xor(ss, 4); ss += __shfl_xor(ss, 8); ss += __shfl_xor(ss, 16);
            const float rstd = 1.0f / sqrtf(ss * (1.f / 128.f) + EPS);
            bf16* orow = AO + (size_t)(mq0 + crow(r, hi)) * DM + h * 128 + r32;
#pragma unroll
            for (int d = 0; d < 4; ++d) orow[32 * d] = (bf16)f2bf(o[d][r] * rstd * gv[d]);
        }
    }
    __syncthreads();
}

__device__ __forceinline__ void dil_unit(Frame& F, int b, int dil, int h, int res, int mblk, float negb) {
    const bf16* QKV = (const bf16*)(F.ws + WS_QKV);
    { unsigned z_; asm volatile("s_mov_b32 %0, 0" : "=s"(z_)); QKV += z_; }
    float* OP = (float*)(F.ws + WS_DILP) + (size_t)b * S * 1024; float* LP = (float*)(F.ws + WS_DILL) + (size_t)b * S * 8;
    int lane = F.lane; asm volatile("" : "+v"(lane));
    const int r32 = lane & 31, hi = lane >> 5;
    const int L = S / dil, m0 = mblk * 256, mq0 = m0 + 32 * F.wave;
    bf16x8 qr[8];
    { const bf16* Qw = QKV + ((size_t)(mq0 + r32) * dil + res) * QKVW + 3072 + h * 128 + hi * 8;
#pragma unroll
      for (int d0 = 0; d0 < 8; ++d0) qr[d0] = *(const bf16x8*)(Qw + d0 * 16); }
    f32x16 o[4];
#pragma unroll
    for (int d = 0; d < 4; ++d)
#pragma unroll
        for (int r = 0; r < 16; ++r) o[d][r] = 0.f;
    float l_reg = 0.f;
    attn_core<8, true>(QKV, dil, res, L, mq0, m0 - 64, 6, 4096 + h * 128, 5120 + h * 128, 0, negb, qr, (char*)F.lds, o, l_reg);
    if (hi == 0) LP[((size_t)(mq0 + r32) * dil + res) * 8 + h] = l_reg;
#pragma unroll
    for (int r = 0; r < 16; ++r) { float* orow = OP + ((size_t)(mq0 + crow(r, hi)) * dil + res) * 1024 + h * 128 + r32;
#pragma unroll
        for (int d = 0; d < 4; ++d) orow[32 * d] = o[d][r]; }
}

__device__ __forceinline__ float vec_absmax(const float* g, int n, int lane) {
    float m = 0.f; for (int i = lane; i < n; i += 64) m = fmaxf(m, fabsf(g[i]));
#pragma unroll
    for (int o = 1; o < 64; o <<= 1) m = fmaxf(m, __shfl_xor(m, o));
    return m;
}
__device__ __forceinline__ void attention_phase(Frame& F, int l) {
    const float* const* P = F.in + 1 + 17 * l;
    float a = 0.f, b = 0.f; { const int i = F.lane; a = P[4][i] * P[5][i]; b = P[6][i] * P[7][i]; }
    a = wave_sum(a); b = wave_sum(b);
    const float lam_init = l == 0 ? 0.2f : 0.35550906759096934f;
    const float lam = __expf(a) - __expf(b) + lam_init;
    const float negbA = -(8.0f * LOG2E * 1.02f) * vec_absmax(P[2], 64, F.lane) * vec_absmax(P[3], 64, F.lane);
    const float negbB = -(11.313708498984761f * LOG2E * 1.02f) * vec_absmax(P[9], 128, F.lane) * vec_absmax(P[10], 128, F.lane);
    for (int u = F.c; u < 8 * 128; u += F.G) diff_unit(F, u & 7, u >> 3, lam, 1.0f - lam_init, negbA, P[8]);
    for (int u = F.c; u < 3 * 512; u += F.G) {
        const int b = u >> 9, idx = u & 511, h = idx & 7, rest = idx >> 3, dil = b == 0 ? 1 : (b == 1 ? 4 : 16), nb = 64 / dil;
        dil_unit(F, b, dil, h, rest / nb, rest % nb, negbB);
    }
}
#ifndef PHASE_MASK
#define PHASE_MASK 0x7ff
#endif
#define PH_ON(k) ((PHASE_MASK >> (k)) & 1)
constexpr int N_PHASES = 21;
struct Args { const float* in[36]; float* out; unsigned char* ws; int ph_lo, ph_hi; };
__global__ void __launch_bounds__(NTHR, 2) fwd_kernel(Args args) {
    extern __shared__ __attribute__((aligned(16))) unsigned char lds[];
    Frame F;
    F.lds = lds; F.tid = threadIdx.x; F.lane = F.tid & 63; F.wave = __builtin_amdgcn_readfirstlane(F.tid >> 6);
    F.G = gridDim.x; F.c = blockIdx.x; F.in = args.in; F.out = args.out; F.ws = args.ws;
    unsigned char* ws = args.ws;
    volatile LAS unsigned* MISC = (volatile LAS unsigned*)((LAS unsigned char*)lds + MISC_OFF);
    if (F.tid < 64) MISC[F.tid] = 0u;
    __syncthreads();
#if MK_PER_PHASE
#define GRID_BAR() do { } while (0)
#else
    XcdBarrier bar = xcd_barrier_post((unsigned*)(ws + WS_CTL) + CW_BAR, MISC + 8);
#define GRID_BAR() xcd_barrier(bar)
#endif
    const int lo = args.ph_lo, hi = args.ph_hi;
#define IN(k) (lo <= (k) && (k) < hi)
#define FRESH() do { unsigned z_; asm volatile("s_mov_b32 %0, 0" : "=s"(z_)); ws = args.ws + z_; F.ws = ws; F.out = args.out + z_; int t_ = threadIdx.x; asm volatile("" : "+v"(t_)); F.tid = t_; F.lane = t_ & 63; F.wave = __builtin_amdgcn_readfirstlane(t_ >> 6); } while (0)
#define SEAM(k) do { if (IN(k) && IN((k) + 1)) GRID_BAR(); } while (0)
    PG8_LAS unsigned char* glds = (PG8_LAS unsigned char*)lds;

    if (IN(0) && PH_ON(10)) { FRESH(); p0_prologue(F); } SEAM(0);

    for (int l = 0; l < 2; ++l) {
        const int pb = 1 + 10 * l;
        if (IN(pb + 0) && PH_ON(0)) { FRESH();
            pg8::Gemm g{(const bf16*)(ws + WS_H), (const bf16*)(ws + WS_WIN) + (size_t)l * QKVW * DM, S, QKVW, DM}; pg8::StaticOrder So; So.init(S, QKVW, F.G, F.c);
            pg8::EpiBf16 E{(bf16*)(ws + WS_QKV), QKVW, 1 << 20};
            pg8::gemm_phase<pg8::EpiBf16, pg8::StaticOrder, false>(glds, g, So, E, nullptr);
        } SEAM(pb + 0);
        if (IN(pb + 1) && PH_ON(1)) { FRESH(); qknorm_rope_phase(F, l); } SEAM(pb + 1);
        if (IN(pb + 2) && PH_ON(2)) { FRESH(); attention_phase(F, l); } SEAM(pb + 2);
        if (IN(pb + 3) && PH_ON(3)) { FRESH(); dil_combine_phase(F, l); } SEAM(pb + 3);
        if (IN(pb + 4) && PH_ON(4)) { FRESH();
            pg8::Gemm g{(const bf16*)(ws + WS_AO), (const bf16*)(ws + WS_WOUT) + (size_t)l * DM * DM, S, DM, DM}; pg8::StaticOrder So; So.init(S, DM, F.G, F.c);
            pg8::EpiRes E{F.out, l == 0 ? F.in[0] : (const float*)F.out, DM};
            pg8::gemm_phase<pg8::EpiRes, pg8::StaticOrder, false>(glds, g, So, E, nullptr);
        } SEAM(pb + 4);
        if (IN(pb + 5) && PH_ON(5)) { FRESH();
            if (l == 0) norm_phase(F, F.out, F.in[14], (bf16*)(ws + WS_H));
            else norm_router_phase(F, F.out, F.in[31], (bf16*)(ws + WS_H), F.in[32]);
        } SEAM(pb + 5);
        if (IN(pb + 6) && PH_ON(6)) { FRESH(); if (l == 1) moe_scatter_phase(F); } SEAM(pb + 6);
        if (IN(pb + 7) && PH_ON(7)) { FRESH();
            if (l == 0) {
                pg8::Gemm g{(const bf16*)(ws + WS_H), (const bf16*)(ws + WS_WGU), S, 2 * DFF, DM}; pg8::StaticOrder So; So.init(S, 2 * DFF, F.G, F.c);
                pg8::EpiSwiGLU E{(bf16*)(ws + WS_HID), DFF, 1 << 20};
                pg8::gemm_phase<pg8::EpiSwiGLU, pg8::StaticOrder, false>(glds, g, So, E, nullptr);
            } else {
                const int* meta = (const int*)(ws + WS_TOK + TK_META);
                pg8::Gemm g{(const bf16*)(ws + WS_XG), (const bf16*)(ws + WS_MGU), MPAD_MAX, NE * 2 * DEXP, DM}; pg8::MoeOrder Mo; Mo.init(meta, 2 * DEXP / 256, F.G, F.c);
                pg8::EpiSwiGLU E{(bf16*)(ws + WS_HID), DEXP, 2 * DEXP / 256};
                pg8::gemm_phase<pg8::EpiSwiGLU, pg8::MoeOrder, false>(glds, g, Mo, E, nullptr);
            }
        } SEAM(pb + 7);
        if (IN(pb + 8) && PH_ON(8)) { FRESH();
            if (l == 0) {
                pg8::Gemm g{(const bf16*)(ws + WS_HID), (const bf16*)(ws + WS_WDN), S, DM, DFF}; pg8::StaticOrder So; So.init(S, DM, F.G, F.c);
                pg8::EpiRes E{F.out, (const float*)F.out, DM};
                pg8::gemm_phase<pg8::EpiRes, pg8::StaticOrder, false>(glds, g, So, E, nullptr);
            } else {
                const int* meta = (const int*)(ws + WS_TOK + TK_META);
                pg8::Gemm g{(const bf16*)(ws + WS_HID), (const bf16*)(ws + WS_MDN), MPAD_MAX, NE * DM, DEXP}; pg8::MoeOrder Mo; Mo.init(meta, DM / 256, F.G, F.c);
                pg8::EpiBf16 E{(bf16*)(ws + WS_YE), DM, DM / 256};
                pg8::gemm_phase<pg8::EpiBf16, pg8::MoeOrder, false>(glds, g, Mo, E, nullptr);
            }
        } SEAM(pb + 8);
        if (IN(pb + 9) && PH_ON(9)) { FRESH();
            if (l == 0) norm_phase(F, F.out, F.in[18], (bf16*)(ws + WS_H));
            else moe_combine_phase(F);
        } SEAM(pb + 9);
    }
#undef IN
#undef SEAM
}

extern "C" void kernel_launch(void* const* d_in, const int* in_sizes, int n_in, void* d_out, int out_size, void* d_ws, size_t ws_size, hipStream_t stream) {
    static int grid = 0;
    if (grid == 0) {
        if (n_in != 36 || in_sizes[0] != S * DM || out_size != S * DM || ws_size < WS_END) {
            fprintf(stderr, "kernel_launch: shape mismatch: n_in %d in0 %d out %d ws %zu (need >= %zu)\n", n_in, n_in > 0 ? in_sizes[0] : -1, out_size, ws_size, (size_t)WS_END); grid = -1; return; }
        int dev = 0, cus = 0, per_cu = 0;
        if (hipGetDevice(&dev) != hipSuccess || hipDeviceGetAttribute(&cus, hipDeviceAttributeMultiprocessorCount, dev) != hipSuccess) { fprintf(stderr, "kernel_launch: device query failed\n"); grid = -1; return; }
        if (hipFuncSetAttribute((const void*)fwd_kernel, hipFuncAttributeMaxDynamicSharedMemorySize, LDS_BYTES) != hipSuccess) { fprintf(stderr, "kernel_launch: hipFuncSetAttribute failed\n"); grid = -1; return; }
        if (hipOccupancyMaxActiveBlocksPerMultiprocessor(&per_cu, (const void*)fwd_kernel, NTHR, LDS_BYTES) != hipSuccess || per_cu < 1)
            fprintf(stderr, "kernel_launch: note: occupancy query reports %d workgroups per CU\n", per_cu);
        (void)hipGetLastError();
        grid = cus;
        if (grid != 256) { fprintf(stderr, "kernel_launch: this kernel needs a 256-CU device (got %d)\n", cus); grid = -1; return; }
    }
    if (grid < 0) return;
    if (hipMemsetAsync((char*)d_ws + WS_CTL, 0, CTL_ZERO_BYTES, stream) != hipSuccess) { fprintf(stderr, "kernel_launch: memset failed\n"); return; }
    Args a{};
    for (int i = 0; i < 36; ++i) a.in[i] = (const float*)d_in[i];
    a.out = (float*)d_out; a.ws = (unsigned char*)d_ws;
#if MK_PER_PHASE
    for (int p = 0; p < N_PHASES; ++p) {
        if (p == 7) continue;
        a.ph_lo = p; a.ph_hi = p + 1;
        hipLaunchKernelGGL(fwd_kernel, dim3(grid), dim3(NTHR), LDS_BYTES, stream, a);
    }
#else
    a.ph_lo = 0; a.ph_hi = N_PHASES;
    hipLaunchKernelGGL(fwd_kernel, dim3(grid), dim3(NTHR), LDS_BYTES, stream, a);
#endif
    const hipError_t le = hipPeekAtLastError();
    if (le != hipSuccess) fprintf(stderr, "kernel_launch: launch failed: %s\n", hipGetErrorName(le));
}
```

```cpp
#include <hip/hip_runtime.h>
#include <cstdio>
#include <cstdint>

#ifndef MK_PER_PHASE
#define MK_PER_PHASE 0
#endif

#define LAS __attribute__((address_space(3)))
#define GAS __attribute__((address_space(1)))
typedef unsigned short bf16;
typedef short bf16x8 __attribute__((ext_vector_type(8)));
typedef short s16x4 __attribute__((ext_vector_type(4)));
typedef float f32x4 __attribute__((ext_vector_type(4)));
typedef float f32x2 __attribute__((ext_vector_type(2)));
typedef float f32x16 __attribute__((ext_vector_type(16)));
typedef unsigned u32x4 __attribute__((ext_vector_type(4)));
typedef unsigned u32x2 __attribute__((ext_vector_type(2)));

constexpr int S = 16384, DM = 2048, QKVW = 6144, DFF = 5632, NE = 8, DEXP = 7168;
constexpr int MPAD_MAX = 2 * S + NE * 256;
constexpr float EPS = 1e-6f;
constexpr float LOG2E = 1.4426950408889634f;

constexpr size_t MiB = 1u << 20;
constexpr size_t WS_CTL = 0, CTL_ZERO_BYTES = 1 * MiB;
constexpr size_t WS_WIN = 2 * MiB;
constexpr size_t WS_WOUT = 50 * MiB;
constexpr size_t WS_WGU = 66 * MiB;
constexpr size_t WS_WDN = 110 * MiB;
constexpr size_t WS_MGU = 132 * MiB;
constexpr size_t WS_MDN = 580 * MiB;
constexpr size_t WS_H = 804 * MiB;
constexpr size_t WS_AO = 868 * MiB;
constexpr size_t WS_ROPE = 932 * MiB;
constexpr size_t WS_TOK = 944 * MiB;
constexpr size_t WS_XG = 946 * MiB;
constexpr size_t WS_V8T = WS_XG + 80 * MiB;
constexpr size_t WS_YE = 1082 * MiB;
constexpr size_t WS_BIG = 1218 * MiB;
constexpr size_t WS_QKV = WS_BIG, WS_DILP = WS_BIG + 192 * MiB, WS_DILL = WS_DILP + 192 * MiB, WS_HID = WS_BIG;
constexpr size_t WS_XRB = WS_BIG + 476 * MiB;
constexpr size_t WS_END = WS_XRB + 64 * MiB;
constexpr size_t TK_E = 0, TK_G = (size_t)S * 2 * 4, TK_POS = (size_t)S * 4 * 4, TK_WGCNT = (size_t)S * 6 * 4, TK_META = TK_WGCNT + 256 * 8 * 4;
constexpr int CW_BAR = 4096;

__device__ __forceinline__ unsigned f2bf(float f) { unsigned u = __builtin_bit_cast(unsigned, f); return (u + 0x7fffu + ((u >> 16) & 1u)) >> 16; }
__device__ __forceinline__ unsigned pk2(float lo, float hi) { return f2bf(lo) | (f2bf(hi) << 16); }
__device__ __forceinline__ float bf2f(unsigned short b) { return __builtin_bit_cast(float, ((unsigned)b) << 16); }
__device__ __forceinline__ float bflo(unsigned w) { return __builtin_bit_cast(float, w << 16); }
__device__ __forceinline__ float bfhi(unsigned w) { return __builtin_bit_cast(float, w & 0xffff0000u); }
__device__ __forceinline__ unsigned cvtpk(float lo, float hi) { unsigned r; asm volatile("v_cvt_pk_bf16_f32 %0, %1, %2" : "=v"(r) : "v"(lo), "v"(hi)); return r; }
#define LDS_WAIT() asm volatile("s_waitcnt lgkmcnt(0)" ::: "memory")
#define VM_WAIT() asm volatile("s_waitcnt vmcnt(0)" ::: "memory")
#define SBAR() __builtin_amdgcn_sched_barrier(0)
__device__ __forceinline__ float shflx(float v, int o, int lane) { return __builtin_bit_cast(float, __builtin_amdgcn_ds_bpermute((lane ^ o) << 2, __builtin_bit_cast(int, v))); }
__device__ __forceinline__ float wave_sum(float v, int lane) {
#pragma unroll
    for (int o = 1; o < 64; o <<= 1) v += shflx(v, o, lane);
    return v;
}
namespace pg8 {
#define PG8_LAS __attribute__((address_space(3)))
typedef unsigned short bf16_t;
typedef short bf16x8 __attribute__((ext_vector_type(8)));
typedef float f32x4 __attribute__((ext_vector_type(4)));
typedef unsigned u32x4 __attribute__((ext_vector_type(4)));
typedef int i32x4 __attribute__((ext_vector_type(4)));
typedef int i32x8 __attribute__((ext_vector_type(8)));
typedef unsigned u32x2v __attribute__((ext_vector_type(2)));
constexpr int BM = 256, BK = 64, HALF = 128, HTB = HALF * BK * 2  , STAGE_BYTES = 8 * HTB, NXCD = 8, WGM = 8;

__host__ __device__ __forceinline__ int lds_byte(int r, int c) { const int st = (r >> 4) * 2 + (c >> 5), rr = r & 15, cc = c & 31, ob = rr * 64 + cc * 2; return st * 1024 + (ob ^ (((ob >> 9) & 1) << 5)); }
__host__ __device__ __forceinline__ void stage_rc(int b, int& R, int& C) { const int st = b / 1024, sb = b % 1024, swz = sb ^ (((sb >> 9) & 1) << 5); R = (st >> 1) * 16 + swz / 64; C = (st & 1) * 32 + (swz % 64) / 2; }
__host__ __device__ __forceinline__ int perm32(int rho) { const int n = rho >> 4, i = rho & 15; return 8 * (i >> 2) + 4 * n + (i & 3); }

struct Unit { int pm, pn; };
struct Gemm { const bf16_t* A; const bf16_t* Bt; int M, N, K; };

struct StaticOrder {
    int nM, nN, nwg, G, c;
    __host__ __device__ void init(int M, int N, int G_, int c_) { nM = M / BM; nN = N / BM; nwg = nM * nN; G = G_; c = c_; }
    __host__ __device__ bool next(int i, Unit& u) const {
        const long L = (long)i * G + c; if (L >= nwg) return false;
        int wgid = (int)L; { const int q = nwg / NXCD, r = nwg % NXCD, xcd = wgid % NXCD, off = wgid / NXCD; wgid = (xcd < r ? xcd * (q + 1) : r * (q + 1) + (xcd - r) * q) + off; }
        const int nig = WGM * nN, gid = wgid / nig, fm = gid * WGM, gsz = (nM - fm) < WGM ? (nM - fm) : WGM;
        u.pm = fm + ((wgid % nig) % gsz); u.pn = (wgid % nig) / gsz; return true;
    }
    __device__ __forceinline__ void a_ready(const Unit&) const {}
    __device__ __forceinline__ void done(const Unit&) const {}
};

struct MoeOrder {
    int ts0, ts1, ts2, ts3, ts4, ts5, ts6, ts7, ts8; int NT, nwg, G, c;
    __device__ void init(const int* tstart, int NT_, int G_, int c_) { ts0 = tstart[0]; ts1 = tstart[1]; ts2 = tstart[2]; ts3 = tstart[3]; ts4 = tstart[4]; ts5 = tstart[5]; ts6 = tstart[6]; ts7 = tstart[7]; ts8 = tstart[8];
        NT = NT_; nwg = ts8 * NT_; G = G_; c = c_; }
    __device__ bool next(int i, Unit& u) const {
        const long L = (long)i * G + c; if (L >= nwg) return false;
        int wgid = (int)L; { const int q = nwg / NXCD, r = nwg % NXCD, xcd = wgid % NXCD, off = wgid / NXCD; wgid = (xcd < r ? xcd * (q + 1) : r * (q + 1) + (xcd - r) * q) + off; }
        const int t = wgid / NT;
        int e = 0, lo = ts0, hi = ts1;
        if (t >= ts1) { e = 1; lo = ts1; hi = ts2; } if (t >= ts2) { e = 2; lo = ts2; hi = ts3; } if (t >= ts3) { e = 3; lo = ts3; hi = ts4; } if (t >= ts4) { e = 4; lo = ts4; hi = ts5; }
        if (t >= ts5) { e = 5; lo = ts5; hi = ts6; } if (t >= ts6) { e = 6; lo = ts6; hi = ts7; } if (t >= ts7) { e = 7; lo = ts7; hi = ts8; }
        const int Te = hi - lo, local = wgid - lo * NT;
        const int nig = WGM * NT, gid = local / nig, fm = gid * WGM, gsz = (Te - fm) < WGM ? (Te - fm) : WGM, rr = local % nig;
        u.pm = lo + fm + rr % gsz; u.pn = e * NT + rr / gsz; return true;
    }
    __device__ __forceinline__ void a_ready(const Unit&) const {}
    __device__ __forceinline__ void done(const Unit&) const {}
};

__device__ __forceinline__ unsigned cvt_pk_bf16(float lo, float hi) { unsigned r; asm volatile("v_cvt_pk_bf16_f32 %0, %1, %2" : "=v"(r) : "v"(lo), "v"(hi)); return r; }

struct EpiBf16 {
    static constexpr bool PERM = true, AFTER_DRAIN = false;
    bf16_t* O; int ldc; int ntn;
    __device__ __forceinline__ void operator()(const f32x4 (&acc)[2][2][4][2], const Unit& u, int wr, int wc, int fr, int fq) const {
        const int row0 = u.pm * BM + wr * 64 + fr; const int colt = (u.pn % ntn) * BM;
        const int col0 = colt + wc * 32 + 8 * fq;
#pragma unroll
        for (int ai = 0; ai < 2; ++ai)
#pragma unroll
            for (int m = 0; m < 4; ++m) { bf16_t* rowp = O + (size_t)(row0 + ai * HALF + m * 16) * ldc + col0;
#pragma unroll
                for (int bj = 0; bj < 2; ++bj) { const f32x4 v0 = acc[ai][bj][m][0], v1 = acc[ai][bj][m][1];
                    u32x4 w; w.x = cvt_pk_bf16(v0[0], v0[1]); w.y = cvt_pk_bf16(v0[2], v0[3]); w.z = cvt_pk_bf16(v1[0], v1[1]); w.w = cvt_pk_bf16(v1[2], v1[3]);
                    *(u32x4*)(rowp + bj * HALF) = w; } }
    }
};
template <bool SCALED>
struct EpiRes {
    static constexpr bool PERM = false, AFTER_DRAIN = false;
    float* C; const float* R; int ldc; float scale;
    __device__ __forceinline__ void operator()(const f32x4 (&acc)[2][2][4][2], const Unit& u, int wr, int wc, int fr, int fq) const {
        const int row0 = u.pm * BM + wr * 64 + fr, col0 = u.pn * BM + wc * 32 + 4 * fq;
        f32x4 cur[2][2], nxt[2][2];
#define ER_OFF(g_) ((size_t)(row0 + ((g_) >> 2) * HALF + ((g_) & 3) * 16) * ldc + col0)
#define ER_LOAD(dst, g_) do { const size_t o_ = ER_OFF(g_); _Pragma("unroll") for (int bj = 0; bj < 2; ++bj) _Pragma("unroll") for (int n = 0; n < 2; ++n) dst[bj][n] = *(const f32x4*)(R + o_ + bj * HALF + n * 16); } while (0)
        ER_LOAD(cur, 0);
#pragma unroll
        for (int g_ = 0; g_ < 8; ++g_) {
            if (g_ < 7) ER_LOAD(nxt, g_ + 1);
            const size_t off = ER_OFF(g_); const int ai = g_ >> 2, m = g_ & 3;
#pragma unroll
            for (int bj = 0; bj < 2; ++bj)
#pragma unroll
                for (int n = 0; n < 2; ++n) *(f32x4*)(C + off + bj * HALF + n * 16) = SCALED ? (acc[ai][bj][m][n] * scale + cur[bj][n]) : (acc[ai][bj][m][n] + cur[bj][n]);
#pragma unroll
            for (int bj = 0; bj < 2; ++bj)
#pragma unroll
                for (int n = 0; n < 2; ++n) cur[bj][n] = nxt[bj][n];
        }
#undef ER_OFF
#undef ER_LOAD
    }
};
template <bool RF32, bool SCALED>
struct EpiResB {
    static constexpr bool PERM = true, AFTER_DRAIN = false;
    bf16_t* C; const void* R; int ldc; float scale;
    __device__ __forceinline__ void operator()(const f32x4 (&acc)[2][2][4][2], const Unit& u, int wr, int wc, int fr, int fq) const {
        const int row0 = u.pm * BM + wr * 64 + fr, col0 = u.pn * BM + wc * 32 + 8 * fq;
        f32x4 cur[2][2], nxt[2][2];
#define EB_OFF(g_) ((size_t)(row0 + ((g_) >> 2) * HALF + ((g_) & 3) * 16) * ldc + col0)
#define EB_LOAD(dst, g_) do { const size_t o_ = EB_OFF(g_); _Pragma("unroll") for (int bj = 0; bj < 2; ++bj) { \
            if (RF32) { dst[bj][0] = *(const f32x4*)((const float*)R + o_ + bj * HALF); dst[bj][1] = *(const f32x4*)((const float*)R + o_ + bj * HALF + 4); } \
            else { const u32x4 w_ = *(const u32x4*)((const bf16_t*)R + o_ + bj * HALF); \
                dst[bj][0] = (f32x4){__builtin_bit_cast(float, w_.x << 16), __builtin_bit_cast(float, w_.x & 0xffff0000u), __builtin_bit_cast(float, w_.y << 16), __builtin_bit_cast(float, w_.y & 0xffff0000u)}; \
                dst[bj][1] = (f32x4){__builtin_bit_cast(float, w_.z << 16), __builtin_bit_cast(float, w_.z & 0xffff0000u), __builtin_bit_cast(float, w_.w << 16), __builtin_bit_cast(float, w_.w & 0xffff0000u)}; } } } while (0)
        EB_LOAD(cur, 0);
#pragma unroll
        for (int g_ = 0; g_ < 8; ++g_) {
            if (g_ < 7) EB_LOAD(nxt, g_ + 1);
            const size_t off = EB_OFF(g_); const int ai = g_ >> 2, m = g_ & 3;
#pragma unroll
            for (int bj = 0; bj < 2; ++bj) { const f32x4 v0 = SCALED ? (acc[ai][bj][m][0] * scale + cur[bj][0]) : (acc[ai][bj][m][0] + cur[bj][0]), v1 = SCALED ? (acc[ai][bj][m][1] * scale + cur[bj][1]) : (acc[ai][bj][m][1] + cur[bj][1]);
                u32x4 w; w.x = cvt_pk_bf16(v0[0], v0[1]); w.y = cvt_pk_bf16(v0[2], v0[3]); w.z = cvt_pk_bf16(v1[0], v1[1]); w.w = cvt_pk_bf16(v1[2], v1[3]);
                *(u32x4*)(C + off + bj * HALF) = w; }
#pragma unroll
            for (int bj = 0; bj < 2; ++bj)
#pragma unroll
                for (int n = 0; n < 2; ++n) cur[bj][n] = nxt[bj][n];
        }
#undef EB_OFF
#undef EB_LOAD
    }
};

__device__ __forceinline__ float silu_mul(float g, float u) { return g * u * __builtin_amdgcn_rcpf(1.0f + __builtin_amdgcn_exp2f(-1.4426950408889634f * g)); }
struct EpiSwiGLU {
    static constexpr bool PERM = true, AFTER_DRAIN = false;
    bf16_t* O; int ldh; int ntn;
    __device__ __forceinline__ void operator()(const f32x4 (&acc)[2][2][4][2], const Unit& u, int wr, int wc, int fr, int fq) const {
        const int row0 = u.pm * BM + wr * 64 + fr; const int col0 = (u.pn % ntn) * HALF + wc * 32 + 8 * fq;
#pragma unroll
        for (int ai = 0; ai < 2; ++ai)
#pragma unroll
            for (int m = 0; m < 4; ++m) { bf16_t* rowp = O + (size_t)(row0 + ai * HALF + m * 16) * ldh + col0;
                const f32x4 g0 = acc[ai][0][m][0], g1 = acc[ai][0][m][1], u0 = acc[ai][1][m][0], u1 = acc[ai][1][m][1];
                u32x4 w; w.x = cvt_pk_bf16(silu_mul(g0[0], u0[0]), silu_mul(g0[1], u0[1])); w.y = cvt_pk_bf16(silu_mul(g0[2], u0[2]), silu_mul(g0[3], u0[3]));
                w.z = cvt_pk_bf16(silu_mul(g1[0], u1[0]), silu_mul(g1[1], u1[1])); w.w = cvt_pk_bf16(silu_mul(g1[2], u1[2]), silu_mul(g1[3], u1[3]));
                *(u32x4*)rowp = w; }
    }
};

__device__ __forceinline__ unsigned pk4_fp8(float a, float b, float c, float d) { int w = 0; w = __builtin_amdgcn_cvt_pk_fp8_f32(a, b, w, false); w = __builtin_amdgcn_cvt_pk_fp8_f32(c, d, w, true); return (unsigned)w; }
__device__ __forceinline__ unsigned pk4_fp8_ip(float a, float b, float c, float d) { int w = __builtin_bit_cast(int, a); w = __builtin_amdgcn_cvt_pk_fp8_f32(a, b, w, false); w = __builtin_amdgcn_cvt_pk_fp8_f32(c, d, w, true); return (unsigned)w; }
template <bool SCALED = true>
struct EpiSwiGLU8 {
    static constexpr bool PERM = true, AFTER_DRAIN = false;
    unsigned char* O; int ldh; int ntn; float scale;
    __device__ __forceinline__ void operator()(const f32x4 (&acc)[2][2][4][2], const Unit& u, int wr, int wc, int fr, int fq) const {
        const int row0 = u.pm * BM + wr * 64 + fr; const int col0 = (u.pn % ntn) * HALF + wc * 32 + 8 * fq;
#pragma unroll
        for (int ai = 0; ai < 2; ++ai)
#pragma unroll
            for (int m = 0; m < 4; ++m) { unsigned char* rowp = O + (size_t)(row0 + ai * HALF + m * 16) * ldh + col0;
                const f32x4 g0 = SCALED ? acc[ai][0][m][0] * scale : acc[ai][0][m][0], g1 = SCALED ? acc[ai][0][m][1] * scale : acc[ai][0][m][1], u0 = SCALED ? acc[ai][1][m][0] * scale : acc[ai][1][m][0], u1 = SCALED ? acc[ai][1][m][1] * scale : acc[ai][1][m][1];
                u32x2v w; w.x = pk4_fp8_ip(silu_mul(g0[0], u0[0]), silu_mul(g0[1], u0[1]), silu_mul(g0[2], u0[2]), silu_mul(g0[3], u0[3]));
                w.y = pk4_fp8_ip(silu_mul(g1[0], u1[0]), silu_mul(g1[1], u1[1]), silu_mul(g1[2], u1[2]), silu_mul(g1[3], u1[3]));
                *(u32x2v*)rowp = w; }
    }
};

struct EpiQKV {
    static constexpr bool PERM = true, AFTER_DRAIN = false;
    bf16_t* O; int ldc;
    const float *cosA, *sinA, *cosB, *sinB;
    const float *dqn, *dkn, *bqn, *bkn;
    PG8_LAS float* xs;
    float eps, qsA, qsB;
    __device__ __forceinline__ static float xlane(float v, int o, int lane) { return __builtin_bit_cast(float, __builtin_amdgcn_ds_bpermute((lane ^ o) << 2, __builtin_bit_cast(int, v))); }
    __device__ __forceinline__ void operator()(const f32x4 (&acc)[2][2][4][2], const Unit& u, int wr, int wc, int fr, int fq) const {
        const int pn = u.pn, row0 = u.pm * BM + wr * 64 + fr, lane = fr + 16 * fq;
        if ((pn >= 8 && pn < 12) || pn >= 20) {
            const int col0 = pn * BM + wc * 32 + 8 * fq;
#pragma unroll
            for (int ai = 0; ai < 2; ++ai)
#pragma unroll
                for (int m = 0; m < 4; ++m) { bf16_t* rowp = O + (size_t)(row0 + ai * HALF + m * 16) * ldc + col0;
#pragma unroll
                    for (int bj = 0; bj < 2; ++bj) { const f32x4 v0 = acc[ai][bj][m][0], v1 = acc[ai][bj][m][1];
                        u32x4 w; w.x = cvt_pk_bf16(v0[0], v0[1]); w.y = cvt_pk_bf16(v0[2], v0[3]); w.z = cvt_pk_bf16(v1[0], v1[1]); w.w = cvt_pk_bf16(v1[2], v1[3]);
                        *(u32x4*)(rowp + bj * HALF) = w; } }
            return;
        }
        const bool grpA = pn < 8;
        const bool isq = grpA ? (pn < 4) : (pn < 16);
        const float* g_dq = dqn; const float* g_dk = dkn; const float* g_bq = bqn; const float* g_bk = bkn; const float q_a = qsA, q_b = qsB;
        const float* t_ca = cosA; const float* t_sa = sinA; const float* t_cb = cosB; const float* t_sb = sinB;
        asm volatile("" : "+s"(g_dq), "+s"(g_dk), "+s"(g_bq), "+s"(g_bk), "+s"(t_ca), "+s"(t_sa), "+s"(t_cb), "+s"(t_sb));
        const float* gain = grpA ? (isq ? g_dq : g_dk) : (isq ? g_bq : g_bk);
        const float qs = isq ? (grpA ? q_a : q_b) : 1.0f;
        const int w1 = wc & 1;
        const int gofs = grpA ? 8 * fq : 32 * w1 + 8 * fq;
        const int hd = grpA ? 32 : 64;
        const f32x4 ga0 = *(const f32x4*)(gain + gofs), ga1 = *(const f32x4*)(gain + gofs + 4), gb0 = *(const f32x4*)(gain + hd + gofs), gb1 = *(const f32x4*)(gain + hd + gofs + 4);
        float ssr[2][4];
#pragma unroll
        for (int ai = 0; ai < 2; ++ai)
#pragma unroll
            for (int m = 0; m < 4; ++m) { float ss = 0.f;
#pragma unroll
                for (int bj = 0; bj < 2; ++bj)
#pragma unroll
                    for (int n = 0; n < 2; ++n) { const f32x4 x = acc[ai][bj][m][n]; ss += (x[0] * x[0] + x[1] * x[1]) + (x[2] * x[2] + x[3] * x[3]); }
                ss += xlane(ss, 16, lane); ss += xlane(ss, 32, lane); ssr[ai][m] = ss; }
        if (!grpA) {
            PG8_LAS float* mine = xs + (wr * 4 + wc) * 128; const PG8_LAS float* other = xs + (wr * 4 + (wc ^ 1)) * 128;
            if (fq == 0) {
#pragma unroll
                for (int ai = 0; ai < 2; ++ai)
#pragma unroll
                    for (int m = 0; m < 4; ++m) mine[ai * 64 + m * 16 + fr] = ssr[ai][m]; }
            asm volatile("s_waitcnt lgkmcnt(0)" ::: "memory"); __builtin_amdgcn_s_barrier(); asm volatile("" ::: "memory");
#pragma unroll
            for (int ai = 0; ai < 2; ++ai)
#pragma unroll
                for (int m = 0; m < 4; ++m) ssr[ai][m] += other[ai * 64 + m * 16 + fr];
        }
        const float invd = grpA ? (1.0f / 64.0f) : (1.0f / 128.0f);
        const float* ct = grpA ? t_ca : t_cb; const float* st = grpA ? t_sa : t_sb;
        const int tw = grpA ? 32 : 64;
        const int col0 = pn * BM + (grpA ? 64 * wc + 8 * fq : 128 * (wc >> 1) + 32 * w1 + 8 * fq);
#pragma unroll
        for (int ai = 0; ai < 2; ++ai)
#pragma unroll
            for (int m = 0; m < 4; ++m) { const int row = row0 + ai * HALF + m * 16;
                const float rstd = qs * __builtin_amdgcn_rsqf(ssr[ai][m] * invd + eps);
                const float* cp = ct + (size_t)row * tw + gofs; const float* sp = st + (size_t)row * tw + gofs;
                const f32x4 c0 = *(const f32x4*)cp, c1 = *(const f32x4*)(cp + 4), s0 = *(const f32x4*)sp, s1 = *(const f32x4*)(sp + 4);
                const f32x4 ya0 = acc[ai][0][m][0] * rstd * ga0, ya1 = acc[ai][0][m][1] * rstd * ga1, yb0 = acc[ai][1][m][0] * rstd * gb0, yb1 = acc[ai][1][m][1] * rstd * gb1;
                const f32x4 oa0 = ya0 * c0 - yb0 * s0, oa1 = ya1 * c1 - yb1 * s1, ob0 = yb0 * c0 + ya0 * s0, ob1 = yb1 * c1 + ya1 * s1;
                bf16_t* rowp = O + (size_t)row * ldc + col0;
                u32x4 w; w.x = cvt_pk_bf16(oa0[0], oa0[1]); w.y = cvt_pk_bf16(oa0[2], oa0[3]); w.z = cvt_pk_bf16(oa1[0], oa1[1]); w.w = cvt_pk_bf16(oa1[2], oa1[3]);
                *(u32x4*)rowp = w;
                w.x = cvt_pk_bf16(ob0[0], ob0[1]); w.y = cvt_pk_bf16(ob0[2], ob0[3]); w.z = cvt_pk_bf16(ob1[0], ob1[1]); w.w = cvt_pk_bf16(ob1[2], ob1[3]);
                *(u32x4*)(rowp + hd) = w; }
    }
};

template <int MODE> struct FragT;
template <> struct FragT<0> { struct T { bf16x8 k0, k1; };
    static __device__ __forceinline__ void ld(T& d, const PG8_LAS unsigned char* p) { d.k0 = *(const PG8_LAS bf16x8*)p; d.k1 = *(const PG8_LAS bf16x8*)(p + 1024); }
    static __device__ __forceinline__ void mma(f32x4& c, const T& b, const T& a) { c = __builtin_amdgcn_mfma_f32_16x16x32_bf16(b.k0, a.k0, c, 0, 0, 0); c = __builtin_amdgcn_mfma_f32_16x16x32_bf16(b.k1, a.k1, c, 0, 0, 0); } };
template <> struct FragT<1> { typedef i32x8 T;
    static __device__ __forceinline__ void ld(T& d, const PG8_LAS unsigned char* p) { const i32x4 lo = *(const PG8_LAS i32x4*)p, hi = *(const PG8_LAS i32x4*)(p + 1024); d = __builtin_shufflevector(lo, hi, 0, 1, 2, 3, 4, 5, 6, 7); }
    static __device__ __forceinline__ void mma(f32x4& c, const T& b, const T& a) { asm volatile("s_nop 1\n\tv_mfma_f32_16x16x128_f8f6f4 %0, %1, %2, %0" : "+v"(c) : "v"(b), "v"(a)); } };

typedef int i32x6 __attribute__((ext_vector_type(6)));
template <> struct FragT<2> { typedef i32x8 T;
    static __device__ __forceinline__ void ld(T& d, const PG8_LAS unsigned char* p) { const i32x4 lo = *(const PG8_LAS i32x4*)p, hi = *(const PG8_LAS i32x4*)(p + 1024); d = __builtin_shufflevector(lo, hi, 0, 1, 2, 3, 4, 5, 6, 7); }
    static __device__ __forceinline__ void mma(f32x4& c, const T& b, const T& a) {
        const i32x6 b6 = __builtin_shufflevector(b, b, 0, 1, 2, 3, 4, 5), a6 = __builtin_shufflevector(a, a, 0, 1, 2, 3, 4, 5); const int sb = b[6], sa = a[6];
        asm volatile("s_nop 1\n\tv_mfma_scale_f32_16x16x128_f8f6f4 %0, %1, %2, %0, %3, %4 op_sel_hi:[0,0,0] cbsz:2 blgp:2" : "+v"(c) : "v"(b6), "v"(a6), "v"(sb), "v"(sa)); } };

template <class Epi, class Sched, bool STAMP = false, bool FP8 = false, bool FP6 = false>
__device__ __forceinline__ void gemm_phase(PG8_LAS unsigned char* lds, const Gemm g, const Sched& S, const Epi& E, unsigned long long* stamps, int tid) {
    asm volatile("" : "+v"(tid));
    const int wid = __builtin_amdgcn_readfirstlane(tid >> 6), lane = tid & 63, wr = wid >> 2, wc = wid & 3, fr = lane & 15, fq = lane >> 4;
    const int K = g.K, nt = K / BK;
    int ts_lo = 0, ts_hi = 0, nts = 0; const unsigned long long rt_entry = STAMP ? (unsigned long long)wall_clock64() : 0ull;
#define PG8_STAMP() do { if (STAMP && wid == 0 && nts < 64) { const unsigned long long _c = (unsigned long long)clock64(); \
        ts_lo = (lane == nts) ? (int)(unsigned)_c : ts_lo; ts_hi = (lane == nts) ? (int)(unsigned)(_c >> 32) : ts_hi; ++nts; } } while (0)
    PG8_STAMP();
    unsigned voffA[2], voffB[2];
#pragma unroll
    for (int i = 0; i < 2; ++i) { int R, C; stage_rc(tid * 16 + i * 8192, R, C); const int Rb = Epi::PERM ? ((R & ~31) + perm32(R & 31)) : R;
        voffA[i] = (unsigned)(R * K + C) * 2u; voffB[i] = (unsigned)(Rb * K + C) * 2u; }
    const unsigned kstep = (unsigned)(BK * 2);
    const unsigned hstep = (unsigned)HALF * K * 2;
    const unsigned tstep = 2 * hstep;
    const unsigned ldsw = (unsigned)wid * 1024u;
    const int aoff = lds_byte(wr * 64 + fr, fq * 8), boff = lds_byte(wc * 32 + fr, fq * 8);
#define PG8_SA(b, h) (((b) * 2 + (h)) * HTB)
#define PG8_SB(b, h) ((4 + (b) * 2 + (h)) * HTB)
    const __amdgpu_buffer_rsrc_t rA = __builtin_amdgcn_make_buffer_rsrc((void*)g.A, 0, 0xffffffffu, 0x00020000), rB = __builtin_amdgcn_make_buffer_rsrc((void*)g.Bt, 0, 0xffffffffu, 0x00020000);
#ifndef PG8_GLOBAL_STAGE
#define PG8_GLOBAL_STAGE 0
#endif
#define PG8_STAGE(rsrc, bufoff, gbase, voff) do { _Pragma("unroll") for (int _i = 0; _i < 2; ++_i) { \
        if (PG8_GLOBAL_STAGE && !FP8) __builtin_amdgcn_global_load_lds((const unsigned*)((&rsrc == &rA ? (const char*)g.A : (const char*)g.Bt) + (size_t)(gbase) + (voff)[_i]), (PG8_LAS unsigned*)(lds + (bufoff) + ldsw + _i * 8192), 16, 0, 0); \
        else __builtin_amdgcn_raw_ptr_buffer_load_lds(rsrc, (PG8_LAS unsigned*)(lds + (bufoff) + ldsw + _i * 8192), 16, (int)(voff)[_i], (int)(gbase), 0, 0); } } while (0)
#define PG8_LDA(dst, b, h) do { _Pragma("unroll") for (int m = 0; m < 4; ++m) FragT<FP8 ? (FP6 ? 2 : 1) : 0>::ld(dst[m], lds + PG8_SA(b, h) + aoff + m * 2048); } while (0)
#define PG8_LDB(dst, b, h) do { _Pragma("unroll") for (int n = 0; n < 2; ++n) FragT<FP8 ? (FP6 ? 2 : 1) : 0>::ld(dst[n], lds + PG8_SB(b, h) + boff + n * 2048); } while (0)
#define PG8_MMA(ai, bj, At, Bt) do { __builtin_amdgcn_s_setprio(1); _Pragma("unroll") for (int m = 0; m < 4; ++m) _Pragma("unroll") for (int n = 0; n < 2; ++n) \
        FragT<FP8 ? (FP6 ? 2 : 1) : 0>::mma(acc[ai][bj][m][n], Bt[n], At[m]); __builtin_amdgcn_s_setprio(0); } while (0)
#define PG8_WAIT_V(n) asm volatile("s_waitcnt vmcnt(" #n ")" ::: "memory")
#define PG8_WAIT_L(n) asm volatile("s_waitcnt lgkmcnt(" #n ")" ::: "memory")
#define PG8_BAR __builtin_amdgcn_s_barrier()
#define PG8_SCHED __builtin_amdgcn_sched_barrier(0)
    Unit cur, nxt; int ui = 0;
    if (!S.next(0, cur)) return;
    f32x4 acc[2][2][4][2];
#pragma unroll
    for (int a = 0; a < 2; ++a)
#pragma unroll
        for (int b = 0; b < 2; ++b)
#pragma unroll
            for (int m = 0; m < 4; ++m)
#pragma unroll
                for (int n = 0; n < 2; ++n) acc[a][b][m][n] = (f32x4){0.f, 0.f, 0.f, 0.f};
    typename FragT<FP8 ? (FP6 ? 2 : 1) : 0>::T At[4], B0[2], B1[2];
    unsigned cA = (unsigned)cur.pm * tstep, cB = (unsigned)cur.pn * tstep;
    S.a_ready(cur);
    PG8_STAGE(rB, PG8_SB(0, 0), cB, voffB); PG8_STAGE(rA, PG8_SA(0, 0), cA, voffA); PG8_STAGE(rB, PG8_SB(0, 1), cB + hstep, voffB); PG8_STAGE(rA, PG8_SA(0, 1), cA + hstep, voffA);
    if (wr == 1) PG8_BAR;
    PG8_WAIT_V(4); PG8_BAR;
    PG8_STAGE(rB, PG8_SB(1, 0), cB + kstep, voffB); PG8_STAGE(rA, PG8_SA(1, 0), cA + kstep, voffA); PG8_STAGE(rB, PG8_SB(1, 1), cB + hstep + kstep, voffB);
    PG8_WAIT_V(6); PG8_BAR;
    PG8_STAMP();
    for (;;) {
        const bool has_next = S.next(ui + 1, nxt);
        const unsigned nA = has_next ? (unsigned)nxt.pm * tstep : cA, nB = has_next ? (unsigned)nxt.pn * tstep : cB;
        for (int t = 0; t < nt; t += 2) {
            const bool last = (t == nt - 2);
            const unsigned a1 = cA + (unsigned)(t + 1) * kstep;
            const unsigned a2 = last ? nA : cA + (unsigned)(t + 2) * kstep, b2 = last ? nB : cB + (unsigned)(t + 2) * kstep;
            const unsigned a3 = a2 + kstep, b3 = b2 + kstep;
            if (last && has_next) S.a_ready(nxt);
            PG8_LDB(B0, 0, 0); PG8_SCHED; PG8_LDA(At, 0, 0); PG8_STAGE(rA, PG8_SA(1, 1), a1 + hstep, voffA);
            PG8_WAIT_L(8); PG8_BAR; PG8_WAIT_L(0); PG8_MMA(0, 0, At, B0); PG8_BAR; PG8_SCHED;
            PG8_LDB(B1, 0, 1); PG8_STAGE(rB, PG8_SB(0, 0), b2, voffB);
            PG8_BAR; PG8_WAIT_L(0); PG8_MMA(0, 1, At, B1); PG8_BAR;
            PG8_LDA(At, 0, 1); PG8_STAGE(rA, PG8_SA(0, 0), a2, voffA);
            PG8_BAR; PG8_WAIT_L(0); PG8_MMA(1, 0, At, B0); PG8_BAR; PG8_SCHED;
            PG8_STAGE(rB, PG8_SB(0, 1), b2 + hstep, voffB);
            PG8_WAIT_V(6); PG8_BAR; PG8_MMA(1, 1, At, B1); PG8_BAR;
            PG8_LDB(B0, 1, 0); PG8_SCHED; PG8_LDA(At, 1, 0); PG8_STAGE(rA, PG8_SA(0, 1), a2 + hstep, voffA);
            PG8_WAIT_L(8); PG8_BAR; PG8_WAIT_L(0); PG8_MMA(0, 0, At, B0); PG8_BAR; PG8_SCHED;
            PG8_LDB(B1, 1, 1); PG8_STAGE(rB, PG8_SB(1, 0), b3, voffB);
            PG8_BAR; PG8_WAIT_L(0); PG8_MMA(0, 1, At, B1); PG8_BAR;
            PG8_LDA(At, 1, 1); PG8_STAGE(rA, PG8_SA(1, 0), a3, voffA);
            PG8_BAR; PG8_WAIT_L(0); PG8_MMA(1, 0, At, B0); PG8_BAR; PG8_SCHED;
            PG8_STAGE(rB, PG8_SB(1, 1), b3 + hstep, voffB);
            PG8_WAIT_V(6); PG8_BAR; PG8_MMA(1, 1, At, B1); PG8_BAR;
        }
        PG8_STAMP();
        if constexpr (FP8) asm volatile("s_nop 15\n\ts_nop 15" ::: "memory");
        if constexpr (!Epi::AFTER_DRAIN) { int ln_; asm volatile("v_mbcnt_lo_u32_b32 %0, -1, 0\n\tv_mbcnt_hi_u32_b32 %0, -1, %0" : "=v"(ln_));
            E(acc, cur, wr, wc, ln_ & 15, ln_ >> 4); S.done(cur); }
        PG8_STAMP();
        if (!has_next) break;
#pragma unroll
        for (int a = 0; a < 2; ++a)
#pragma unroll
            for (int b = 0; b < 2; ++b)
#pragma unroll
                for (int m = 0; m < 4; ++m)
#pragma unroll
                    for (int n = 0; n < 2; ++n) acc[a][b][m][n] = (f32x4){0.f, 0.f, 0.f, 0.f};
        cur = nxt; cA = nA; cB = nB; ++ui;
    }
    PG8_WAIT_V(0);
    if (wr == 0) PG8_BAR;
    PG8_BAR;
    if constexpr (Epi::AFTER_DRAIN) { E.fused(acc, cur, wr, wc, fr, fq, lds, wid, lane); S.done(cur); }
    PG8_STAMP();
    if (STAMP && wid == 0) { stamps[lane] = lane < nts ? (((unsigned long long)(unsigned)ts_hi << 32) | (unsigned)ts_lo) : 0ull;
        if (lane == 62) stamps[62] = rt_entry; if (lane == 63) stamps[63] = (unsigned long long)wall_clock64(); }
#undef PG8_STAMP
#undef PG8_SA
#undef PG8_SB
#undef PG8_STAGE
#undef PG8_LDA
#undef PG8_LDB
#undef PG8_MMA
#undef PG8_WAIT_V
#undef PG8_WAIT_L
#undef PG8_BAR
#undef PG8_SCHED
}
}
#define XB_TMO      128
#define XB_XCNT(j)  (256  + 64 * (j))
#define XB_XSUB(j)  (1280 + 64 * (j))
#define XB_XGEN(j)  (2304 + 64 * (j))
#define XB_TOP      3328
#define XB_TOPGEN   3392
#define XCD_BAR_WORDS 3456
#define XB_SPIN_CAP (1u << 21)

__device__ __forceinline__ unsigned xb_ld(unsigned* p)              { return __hip_atomic_load(p, __ATOMIC_RELAXED, __HIP_MEMORY_SCOPE_AGENT); }
__device__ __forceinline__ unsigned xb_add(unsigned* p, unsigned v) { return __hip_atomic_fetch_add(p, v, __ATOMIC_RELAXED, __HIP_MEMORY_SCOPE_AGENT); }
__device__ __forceinline__ unsigned xb_xcc_id() { return (unsigned)__builtin_amdgcn_s_getreg((3 << 11) | 20) & 0xFu; }
#define XB_SPIN(cond, bar) do { unsigned _sp = 0; while (cond) { __builtin_amdgcn_s_sleep(1); \
    if ((++_sp & 255u) == 0u) { if (xb_ld(&(bar)[XB_TMO])) break; if (_sp > XB_SPIN_CAP) { atomicAdd(&(bar)[XB_TMO], 1u); break; } } } } while (0)

struct XcdBarrier {
    unsigned* bar; unsigned x;
    volatile LAS unsigned* st;
};

__device__ __forceinline__ XcdBarrier xcd_barrier_post(unsigned* bar, volatile LAS unsigned* st, bool is_t0) {
    XcdBarrier b; b.bar = bar; b.x = xb_xcc_id(); b.st = st;
    if (is_t0) (void)xb_add(&bar[XB_XCNT(b.x)], 1u);
    return b;
}
__device__ __forceinline__ void xcd_barrier_complete(unsigned* bar, unsigned x, unsigned& nloc, unsigned& nx) {
    const unsigned G = gridDim.x * gridDim.y * gridDim.z;
    unsigned sum, cnt, mine, sp = 0u;
    for (;;) {
        sum = 0u; cnt = 0u; mine = 0u;
#pragma unroll
        for (unsigned j = 0; j < 16; ++j) { const unsigned c = xb_ld(&bar[XB_XCNT(j)]); sum += c; cnt += (c > 0u) ? 1u : 0u; mine = (j == x) ? c : mine; }
        if (sum == G) break;
        __builtin_amdgcn_s_sleep(1);
        if ((++sp & 255u) == 0u) { if (xb_ld(&bar[XB_TMO])) break; if (sp > XB_SPIN_CAP) { atomicAdd(&bar[XB_TMO], 1u); break; } }
    }
    nloc = mine > 0u ? mine : 1u; nx = cnt > 0u ? cnt : 1u;
}

__device__ __forceinline__ void xcd_barrier(const XcdBarrier& b, bool is_t0) {
    asm volatile("s_waitcnt vmcnt(0)" ::: "memory");
    __syncthreads();
    if (is_t0) {
        unsigned* bar = b.bar;
        __builtin_amdgcn_s_waitcnt(0);
        unsigned nloc = b.st[0], nx = b.st[1];
        if (nloc == 0u) { xcd_barrier_complete(bar, b.x, nloc, nx); b.st[0] = nloc; b.st[1] = nx; }
        const unsigned old = xb_add(&bar[XB_XSUB(b.x)], 1u);
        const unsigned gen = old / nloc;
        if (old + 1u == (gen + 1u) * nloc) {
            __builtin_amdgcn_fence(__ATOMIC_RELEASE, "agent");
            asm volatile("s_waitcnt vmcnt(0)" ::: "memory");
            const unsigned og = xb_add(&bar[XB_TOP], 1u);
            const unsigned tg = og / nx;
            if (og + 1u == (tg + 1u) * nx) xb_add(&bar[XB_TOPGEN], 1u);
            else XB_SPIN(xb_ld(&bar[XB_TOPGEN]) == tg, bar);
            __builtin_amdgcn_fence(__ATOMIC_ACQUIRE, "agent");
            xb_add(&bar[XB_XGEN(b.x)], 1u);
            asm volatile("s_waitcnt vmcnt(0)" ::: "memory");
        } else {
            XB_SPIN(xb_ld(&bar[XB_XGEN(b.x)]) == gen, bar);
            __builtin_amdgcn_fence(__ATOMIC_ACQUIRE, "agent");
            asm volatile("s_waitcnt vmcnt(0)" ::: "memory");
        }
    }
    __syncthreads();
}

#ifndef DENSE_GU_FP8
#define DENSE_GU_FP8 1
#endif
#ifndef DENSE_DN_FP8
#define DENSE_DN_FP8 1
#endif
constexpr int NWAVES = 8, NTHR = 512;
constexpr float W8SCALE = 64.0f, W8INV = 1.0f / 64.0f;
constexpr int RING_BYTES = 131072;
constexpr int MISC_OFF = RING_BYTES;
constexpr int LDS_BYTES = 147456;

struct Frame {
    unsigned char* lds;
    int tid, lane, wave, G, c;
    const float* const* in;
    float* out; unsigned char* ws;
};

__device__ __forceinline__ int win_row(int c) {
    const int pn = c >> 8, r = c & 255, t = r & 31;
    if (pn < 8) return (pn << 8) + 128 * ((r >> 5) & 1) + 32 * (r >> 6) + t;
    if (pn >= 12 && pn < 20) return (pn << 8) + 128 * ((r >> 6) & 1) + 32 * (2 * (r >> 7) + ((r >> 5) & 1)) + t;
    return c;
}
template <bool GU, bool WIN = false>
__device__ __forceinline__ void tr_item(const float* __restrict__ W, int K, int N, bf16* __restrict__ WT, int upoff, float* scr, int item, int lane) {
    const int nblk = N / 32, kb = item / nblk, nb = item % nblk, k0 = 64 * kb, n0 = 32 * nb;
    float v[32];
#pragma unroll
    for (int i = 0; i < 32; ++i) { const int kk = 2 * i + (lane >> 5); v[i] = W[(size_t)(k0 + kk) * N + n0 + (lane & 31)]; }
#pragma unroll
    for (int i = 0; i < 32; ++i) { const int kk = 2 * i + (lane >> 5); scr[kk * 33 + (lane & 31)] = v[i]; }
    LDS_WAIT(); asm volatile("" ::: "memory");
    const int c = lane & 7;
#pragma unroll
    for (int j = 0; j < 4; ++j) { const int n = (lane >> 3) + 8 * j; const float* s = scr + (8 * c) * 33 + n;
        u32x4 o; o.x = pk2(s[0 * 33], s[1 * 33]); o.y = pk2(s[2 * 33], s[3 * 33]); o.z = pk2(s[4 * 33], s[5 * 33]); o.w = pk2(s[6 * 33], s[7 * 33]);
        const int np = n0 + n; const int orow = GU ? (((np >> 7) << 8) + (np & 127) + upoff) : (WIN ? win_row(np) : np);
        *(u32x4*)(WT + (size_t)orow * K + k0 + 8 * c) = o; }
    LDS_WAIT(); asm volatile("" ::: "memory");
}

template <bool GU>
__device__ __forceinline__ void tr_item8(const float* __restrict__ W, int K, int N, unsigned char* __restrict__ WT, int upoff, float wscale, float* scr, int item, int lane) {
    const int nblk = N / 32, kb = item / nblk, nb = item % nblk, k0 = 64 * kb, n0 = 32 * nb;
    float v[32];
#pragma unroll
    for (int i = 0; i < 32; ++i) { const int kk = 2 * i + (lane >> 5); v[i] = W[(size_t)(k0 + kk) * N + n0 + (lane & 31)]; }
#pragma unroll
    for (int i = 0; i < 32; ++i) { const int kk = 2 * i + (lane >> 5); scr[kk * 33 + (lane & 31)] = v[i] * wscale; }
    LDS_WAIT(); asm volatile("" ::: "memory");
    const int c = lane & 3;
#pragma unroll
    for (int j = 0; j < 2; ++j) { const int n = (lane >> 2) + 16 * j; const float* s = scr + (16 * c) * 33 + n;
        u32x4 o; o.x = pg8::pk4_fp8(s[0 * 33], s[1 * 33], s[2 * 33], s[3 * 33]); o.y = pg8::pk4_fp8(s[4 * 33], s[5 * 33], s[6 * 33], s[7 * 33]);
        o.z = pg8::pk4_fp8(s[8 * 33], s[9 * 33], s[10 * 33], s[11 * 33]); o.w = pg8::pk4_fp8(s[12 * 33], s[13 * 33], s[14 * 33], s[15 * 33]);
        const int np = n0 + n; const int orow = GU ? (((np >> 7) << 8) + (np & 127) + upoff) : np;
        *(u32x4*)(WT + (size_t)orow * K + k0 + 16 * c) = o; }
    LDS_WAIT(); asm volatile("" ::: "memory");
}

#ifndef GU_FP6
#define GU_FP6 1
#endif
typedef unsigned u32x6 __attribute__((ext_vector_type(6)));
__device__ __forceinline__ void mx6_block(const float (&x)[32], u32x4& p0, u32x4& p1) {
    float m = 0.f;
#pragma unroll
    for (int i = 0; i < 32; ++i) m = fmaxf(m, fabsf(x[i]));
    const unsigned mb = __builtin_bit_cast(unsigned, m);
    int ex = (int)((mb >> 23) & 255u) - 126;
    const unsigned fb = (mb & 0x007fffffu) | 0x3f000000u;
    int e = ex - 3 + ((__builtin_bit_cast(float, fb) > 0.9375f) ? 1 : 0);
    e = e < -126 ? -126 : e;
    const float scale = __builtin_bit_cast(float, (unsigned)(e + 127) << 23);
    f32x16 a, b;
#pragma unroll
    for (int i = 0; i < 16; ++i) { a[i] = x[i]; b[i] = x[16 + i]; }
    u32x6 d;
    asm volatile("v_cvt_scalef32_2xpk16_fp6_f32 %0, %1, %2, %3" : "=&v"(d) : "v"(a), "v"(b), "v"(scale));
    p0 = (u32x4){d[0], d[1], d[2], d[3]}; p1 = (u32x4){d[4], d[5], (unsigned)(e + 127), 0u};
}
__device__ __forceinline__ int mx6_off(int kb32) { return (kb32 >> 2) * 128 + (kb32 & 3) * 16; }
__device__ __forceinline__ void tr6_finish(const float (&v)[32], int K, unsigned char* __restrict__ WT, bool gu, int upoff, float* scr, int kb, int nb, int lane) {
    const int k0 = 64 * kb, n0 = 32 * nb;
#pragma unroll
    for (int i = 0; i < 32; ++i) { const int kk = 2 * i + (lane >> 5); scr[kk * 33 + (lane & 31)] = v[i]; }
    LDS_WAIT(); asm volatile("" ::: "memory");
    const int n = lane & 31, half = lane >> 5;
    float x[32];
#pragma unroll
    for (int i = 0; i < 32; ++i) x[i] = scr[(32 * half + i) * 33 + n];
    u32x4 p0, p1; mx6_block(x, p0, p1);
    const int np = n0 + n; const int orow = gu ? (((np >> 7) << 8) + (np & 127) + upoff) : np;
    unsigned char* dst = WT + (size_t)orow * K + mx6_off((k0 >> 5) + half);
    *(u32x4*)dst = p0; *(u32x4*)(dst + 64) = p1;
    LDS_WAIT(); asm volatile("" ::: "memory");
}

__device__ __forceinline__ void tr8_load(float (&v)[32], const float* __restrict__ W, int N, int kb, int nb, int lane) {
    const int k0 = 64 * kb, n0 = 32 * nb;
#pragma unroll
    for (int i = 0; i < 32; ++i) { const int kk = 2 * i + (lane >> 5); v[i] = __builtin_nontemporal_load(W + (size_t)(k0 + kk) * N + n0 + (lane & 31)); }
}
__device__ __forceinline__ void tr8_finish(const float (&v)[32], int K, int N, unsigned char* __restrict__ WT, bool gu, int upoff, float wscale, float* scr, int kb, int nb, int lane) {
    const int k0 = 64 * kb, n0 = 32 * nb;
#pragma unroll
    for (int i = 0; i < 32; ++i) { const int kk = 2 * i + (lane >> 5); scr[kk * 33 + (lane & 31)] = v[i] * wscale; }
    LDS_WAIT(); asm volatile("" ::: "memory");
    const int c = lane & 3;
#pragma unroll
    for (int j = 0; j < 2; ++j) { const int n = (lane >> 2) + 16 * j; const float* s = scr + (16 * c) * 33 + n;
        u32x4 o; o.x = pg8::pk4_fp8(s[0 * 33], s[1 * 33], s[2 * 33], s[3 * 33]); o.y = pg8::pk4_fp8(s[4 * 33], s[5 * 33], s[6 * 33], s[7 * 33]);
        o.z = pg8::pk4_fp8(s[8 * 33], s[9 * 33], s[10 * 33], s[11 * 33]); o.w = pg8::pk4_fp8(s[12 * 33], s[13 * 33], s[14 * 33], s[15 * 33]);
        const int np = n0 + n; const int orow = gu ? (((np >> 7) << 8) + (np & 127) + upoff) : np;
        *(u32x4*)(WT + (size_t)orow * K + k0 + 16 * c) = o; }
    LDS_WAIT(); asm volatile("" ::: "memory");
}
struct MoeItem { const float* W; unsigned char* WT; int K, N, r, kb2, upoff; bool gu; };

template <bool F8 = false, bool XB = false>
__device__ __forceinline__ void rms_row(const float* __restrict__ xrow, const float* __restrict__ g, bf16* __restrict__ orow, int lane, f32x4 (&v)[8]) {
    const f32x4* xr = (const f32x4*)xrow + lane; const u32x2* xb = (const u32x2*)xrow + lane; float s = 0.f;
#pragma unroll
    for (int j = 0; j < 8; ++j) { if (XB) { const u32x2 w = xb[64 * j]; v[j] = (f32x4){bflo(w.x), bfhi(w.x), bflo(w.y), bfhi(w.y)}; } else v[j] = xr[64 * j];
        s += (v[j].x * v[j].x + v[j].y * v[j].y) + (v[j].z * v[j].z + v[j].w * v[j].w); }
    const float rstd = 1.0f / sqrtf(wave_sum(s, lane) * (1.f / DM) + EPS);
    const f32x4* gr = (const f32x4*)g + lane;
    unsigned long long* o8 = (unsigned long long*)orow + lane;
#pragma unroll
    for (int j = 0; j < 8; ++j) { const f32x4 gg = gr[64 * j]; v[j] = v[j] * rstd * gg;
        if (F8) ((unsigned*)orow)[64 * j + lane] = pg8::pk4_fp8(v[j].x, v[j].y, v[j].z, v[j].w);
        else o8[64 * j] = (unsigned long long)pk2(v[j].x, v[j].y) | ((unsigned long long)pk2(v[j].z, v[j].w) << 32); }
}

template <bool F8 = false, bool XB = false>
__device__ __forceinline__ void norm_phase(Frame& F, const void* X, const float* g, bf16* H) {
    const int gw = F.c * NWAVES + F.wave, NGW = F.G * NWAVES;
    for (int m = gw; m < S; m += NGW) { f32x4 v[8]; const float* xrow = XB ? (const float*)((const bf16*)X + (size_t)m * DM) : (const float*)X + (size_t)m * DM;
        rms_row<F8, XB>(xrow, g, F8 ? (bf16*)((unsigned char*)H + (size_t)m * DM) : H + (size_t)m * DM, F.lane, v); }
}

template <bool XB>
__device__ __forceinline__ void rms_row6(const void* __restrict__ xrow, const float* __restrict__ g, unsigned char* __restrict__ orow, int lane, float (&y)[32]) {
    if (XB) { const u32x4* xb = (const u32x4*)xrow + 4 * lane;
#pragma unroll
        for (int q = 0; q < 4; ++q) { const u32x4 w = xb[q]; y[8 * q] = bflo(w.x); y[8 * q + 1] = bfhi(w.x); y[8 * q + 2] = bflo(w.y); y[8 * q + 3] = bfhi(w.y);
            y[8 * q + 4] = bflo(w.z); y[8 * q + 5] = bfhi(w.z); y[8 * q + 6] = bflo(w.w); y[8 * q + 7] = bfhi(w.w); } }
    else { const f32x4* xf = (const f32x4*)xrow + 8 * lane;
#pragma unroll
        for (int q = 0; q < 8; ++q) { const f32x4 w = xf[q]; y[4 * q] = w.x; y[4 * q + 1] = w.y; y[4 * q + 2] = w.z; y[4 * q + 3] = w.w; } }
    float s = 0.f;
#pragma unroll
    for (int i = 0; i < 32; ++i) s += y[i] * y[i];
    const float rstd = 1.0f / sqrtf(wave_sum(s, lane) * (1.f / DM) + EPS);
    const f32x4* gr = (const f32x4*)g + 8 * lane;
#pragma unroll
    for (int q = 0; q < 8; ++q) { const f32x4 gg = gr[q]; y[4 * q] *= rstd * gg.x; y[4 * q + 1] *= rstd * gg.y; y[4 * q + 2] *= rstd * gg.z; y[4 * q + 3] *= rstd * gg.w; }
    u32x4 p0, p1; mx6_block(y, p0, p1);
    unsigned char* dst = orow + mx6_off(lane);
    *(u32x4*)dst = p0; *(u32x4*)(dst + 64) = p1;
}
template <bool XB>
__device__ __forceinline__ void norm6_phase(Frame& F, const void* X, const float* g, unsigned char* H6) {
    const int gw = F.c * NWAVES + F.wave, NGW = F.G * NWAVES;
    for (int m = gw; m < S; m += NGW) { float y[32]; rms_row6<XB>(XB ? (const void*)((const bf16*)X + (size_t)m * DM) : (const void*)((const float*)X + (size_t)m * DM), g, H6 + (size_t)m * DM, F.lane, y); }
}

__device__ __forceinline__ void p0_prologue(Frame& F) {
    float* scr = (float*)(F.lds + F.wave * 16384);
    const int gw = F.c * NWAVES + F.wave, NGW = F.G * NWAVES;
    unsigned char* ws = F.ws;
    constexpr int I_IN = (DM / 64) * (QKVW / 32), I_OUT = (DM / 64) * (DM / 32), I_GU = (DM / 64) * (DFF / 32), I_DN = (DFF / 64) * (DM / 32);
    constexpr int I_MGU = (DM / 64) * (DEXP / 32), I_MDN = (DEXP / 64) * (DM / 32);
    constexpr int NSMALL = 2 * I_IN + 2 * I_OUT + 2 * I_GU + I_DN;
    for (int it = gw; it < NSMALL; it += NGW) {
        int r = it;
        if (r < 2 * I_IN) { const int l = r / I_IN; r -= l * I_IN; tr_item<false, true>(F.in[2 + 17 * l], DM, QKVW, (bf16*)(ws + WS_WIN) + (size_t)l * QKVW * DM, 0, scr, r, F.lane); continue; } r -= 2 * I_IN;
        if (r < 2 * I_OUT) { const int l = r / I_OUT; r -= l * I_OUT; tr_item<false>(F.in[13 + 17 * l], DM, DM, (bf16*)(ws + WS_WOUT) + (size_t)l * DM * DM, 0, scr, r, F.lane); continue; } r -= 2 * I_OUT;
#if DENSE_GU_FP8
#if GU_FP6
        if (r < 2 * I_GU) { const int up = r / I_GU; r -= up * I_GU; float vv[32]; const int nblk_ = DFF / 32; tr8_load(vv, F.in[15 + up], DFF, r / nblk_, r % nblk_, F.lane);
            tr6_finish(vv, DM, (unsigned char*)(ws + WS_WGU), true, up * 128, scr, r / nblk_, r % nblk_, F.lane); continue; } r -= 2 * I_GU;
#else
        if (r < 2 * I_GU) { const int up = r / I_GU; r -= up * I_GU; tr_item8<true>(F.in[15 + up], DM, DFF, (unsigned char*)(ws + WS_WGU), up * 128, W8SCALE, scr, r, F.lane); continue; } r -= 2 * I_GU;
#endif
#else
        if (r < 2 * I_GU) { const int up = r / I_GU; r -= up * I_GU; tr_item<true>(F.in[15 + up], DM, DFF, (bf16*)(ws + WS_WGU), up * 128, scr, r, F.lane); continue; } r -= 2 * I_GU;
#endif
#if DENSE_DN_FP8
        tr_item8<false>(F.in[17], DFF, DM, (unsigned char*)(ws + WS_WDN), 0, W8SCALE, scr, r, F.lane);
#else
        tr_item<false>(F.in[17], DFF, DM, (bf16*)(ws + WS_WDN), 0, scr, r, F.lane);
#endif
    }
    {
        static_assert(I_MGU == I_MDN, "item counts");
        constexpr int NPM = I_MGU / 2, NPAIR = 3 * NE * NPM;
        const float* const* in = F.in;
#define MOE_PAIR(pp) ({ MoeItem m_; const int which_ = (pp) / (NE * NPM); int r_ = (pp) - which_ * (NE * NPM); const int e_ = r_ / NPM; r_ -= e_ * NPM; \
            if (which_ < 2) { m_.W = in[33 + which_] + (size_t)e_ * DM * DEXP; m_.WT = (unsigned char*)(ws + WS_MGU) + (size_t)e_ * 2 * DEXP * DM; m_.K = DM; m_.N = DEXP; m_.upoff = which_ * 128; m_.gu = true; } \
            else { m_.W = in[35] + (size_t)e_ * DEXP * DM; m_.WT = (unsigned char*)(ws + WS_MDN) + (size_t)e_ * DM * DEXP; m_.K = DEXP; m_.N = DM; m_.upoff = 0; m_.gu = false; } \
            const int nblk_ = m_.N / 32; m_.r = r_ % nblk_  ; m_.kb2 = r_ / nblk_; m_; })
        float va[32], vb[32];
        if (gw < NPAIR) { const MoeItem m = MOE_PAIR(gw); tr8_load(va, m.W, m.N, 2 * m.kb2, m.r, F.lane); }
        for (int pp = gw; pp < NPAIR; pp += NGW) {
            const MoeItem m = MOE_PAIR(pp);
            tr8_load(vb, m.W, m.N, 2 * m.kb2 + 1, m.r, F.lane);
            if (GU_FP6 && m.gu) tr6_finish(va, m.K, m.WT, true, m.upoff, scr, 2 * m.kb2, m.r, F.lane);
            else tr8_finish(va, m.K, m.N, m.WT, m.gu, m.upoff, W8SCALE, scr, 2 * m.kb2, m.r, F.lane);
            if (pp + NGW < NPAIR) { const MoeItem m2 = MOE_PAIR(pp + NGW); tr8_load(va, m2.W, m2.N, 2 * m2.kb2, m2.r, F.lane); }
            if (GU_FP6 && m.gu) tr6_finish(vb, m.K, m.WT, true, m.upoff, scr, 2 * m.kb2 + 1, m.r, F.lane);
            else tr8_finish(vb, m.K, m.N, m.WT, m.gu, m.upoff, W8SCALE, scr, 2 * m.kb2 + 1, m.r, F.lane);
        }
#undef MOE_PAIR
    }
    {
        float* cosA = (float*)(ws + WS_ROPE); float* sinA = cosA + (size_t)S * 32; float* cosB = sinA + (size_t)S * 32; float* sinB = cosB + (size_t)S * 64;
        const int gt = F.c * NTHR + F.tid, NGT = F.G * NTHR;
        for (int idx = gt; idx < S * 96; idx += NGT) {
            const int pos = idx / 96, j = idx % 96; const bool isA = j < 32; const int i = isA ? j : j - 32;
            const double r = isA ? 0.7498942093324559 : 0.8659643233600653;
            double inv = 1.0; for (int q = 0; q < i; ++q) inv *= r;
            double t = (double)pos * inv * 0.15915494309189535; t -= __builtin_rint(t);
            const float tf = (float)t; const float sn = __builtin_amdgcn_sinf(tf), cs = __builtin_amdgcn_cosf(tf);
            if (isA) { cosA[(size_t)pos * 32 + i] = cs; sinA[(size_t)pos * 32 + i] = sn; } else { cosB[(size_t)pos * 64 + i] = cs; sinB[(size_t)pos * 64 + i] = sn; }
        }
    }
    norm_phase<false, false>(F, F.in[0], F.in[1], (bf16*)(ws + WS_H));
}

template <int GRP>
__device__ __forceinline__ void qknorm_rope_seg(bf16* seg, const float* __restrict__ gain, const float* __restrict__ ct, const float* __restrict__ st, float qscale, int lane) {
    constexpr int DIMS = GRP * 16, HALFD = DIMS / 2;
    u32x4 w0 = *(const u32x4*)(seg + 16 * lane), w1 = *(const u32x4*)(seg + 16 * lane + 8);
    float x[16];
    x[0] = bflo(w0.x); x[1] = bfhi(w0.x); x[2] = bflo(w0.y); x[3] = bfhi(w0.y); x[4] = bflo(w0.z); x[5] = bfhi(w0.z); x[6] = bflo(w0.w); x[7] = bfhi(w0.w);
    x[8] = bflo(w1.x); x[9] = bfhi(w1.x); x[10] = bflo(w1.y); x[11] = bfhi(w1.y); x[12] = bflo(w1.z); x[13] = bfhi(w1.z); x[14] = bflo(w1.w); x[15] = bfhi(w1.w);
    float ss = 0.f;
#pragma unroll
    for (int e = 0; e < 16; ++e) ss += x[e] * x[e];
#pragma unroll
    for (int o = 1; o < GRP; o <<= 1) ss += shflx(ss, o, lane);
    const float rstd = 1.0f / sqrtf(ss * (1.f / DIMS) + EPS);
    const int j0 = 16 * (lane & (GRP - 1));
    const int jj0 = j0 & (HALFD - 1);
    const bool first = j0 < HALFD;
    float y[16], o[16];
#pragma unroll
    for (int e = 0; e < 16; ++e) y[e] = x[e] * rstd * gain[j0 + e];
#pragma unroll
    for (int e = 0; e < 16; ++e) { const float p = shflx(y[e], GRP / 2, lane); const float cs = ct[jj0 + e], sn = st[jj0 + e];
        o[e] = (y[e] * cs + (first ? -p : p) * sn) * qscale; }
    u32x4 r0, r1;
    r0.x = pk2(o[0], o[1]); r0.y = pk2(o[2], o[3]); r0.z = pk2(o[4], o[5]); r0.w = pk2(o[6], o[7]);
    r1.x = pk2(o[8], o[9]); r1.y = pk2(o[10], o[11]); r1.z = pk2(o[12], o[13]); r1.w = pk2(o[14], o[15]);
    *(u32x4*)(seg + 16 * lane) = r0; *(u32x4*)(seg + 16 * lane + 8) = r1;
}
__device__ __forceinline__ void qknorm_rope_phase(Frame& F, int l, size_t qkv_off = WS_QKV) {
    const int gw = F.c * NWAVES + F.wave, NGW = F.G * NWAVES;
    bf16* QKV = (bf16*)(F.ws + qkv_off);
    const float* cosA = (const float*)(F.ws + WS_ROPE); const float* sinA = cosA + (size_t)S * 32; const float* cosB = sinA + (size_t)S * 32; const float* sinB = cosB + (size_t)S * 64;
    const float* dqn = F.in[1 + 17 * l + 2]; const float* dkn = F.in[1 + 17 * l + 3]; const float* bqn = F.in[1 + 17 * l + 9]; const float* bkn = F.in[1 + 17 * l + 10];
    for (int m = gw; m < S; m += NGW) {
        bf16* row = QKV + (size_t)m * QKVW;
        qknorm_rope_seg<4>(row, dqn, cosA + (size_t)m * 32, sinA + (size_t)m * 32, 0.125f * LOG2E, F.lane);
        qknorm_rope_seg<4>(row + 1024, dkn, cosA + (size_t)m * 32, sinA + (size_t)m * 32, 1.0f, F.lane);
        qknorm_rope_seg<8>(row + 3072, bqn, cosB + (size_t)m * 64, sinB + (size_t)m * 64, 0.08838834764831845f * LOG2E, F.lane);
        qknorm_rope_seg<8>(row + 4096, bkn, cosB + (size_t)m * 64, sinB + (size_t)m * 64, 1.0f, F.lane);
    }
}

__device__ __forceinline__ void dil_combine_phase(Frame& F, int l) {
    const int gw = F.c * NWAVES + F.wave, NGW = F.G * NWAVES, lane = F.lane;
    const bf16* OP = (const bf16*)(F.ws + WS_DILP); const float* LP = (const float*)(F.ws + WS_DILL);
    bf16* AO = (bf16*)(F.ws + WS_AO); const float* bon = F.in[1 + 17 * l + 11];
    const int head = lane >> 3, cb = (16 * lane) & 127;
    for (int m = gw; m < S; m += NGW) {
        f32x4 a[4]; float ls = 0.f;
#pragma unroll
        for (int q = 0; q < 4; ++q) a[q] = (f32x4){0.f, 0.f, 0.f, 0.f};
#pragma unroll
        for (int b = 0; b < 3; ++b) { const u32x4* p = (const u32x4*)(OP + ((size_t)b * S + m) * 1024 + 16 * lane); const u32x4 w0 = p[0], w1 = p[1];
            a[0] += (f32x4){bflo(w0.x), bfhi(w0.x), bflo(w0.y), bfhi(w0.y)}; a[1] += (f32x4){bflo(w0.z), bfhi(w0.z), bflo(w0.w), bfhi(w0.w)};
            a[2] += (f32x4){bflo(w1.x), bfhi(w1.x), bflo(w1.y), bfhi(w1.y)}; a[3] += (f32x4){bflo(w1.z), bfhi(w1.z), bflo(w1.w), bfhi(w1.w)};
            ls += LP[((size_t)b * S + m) * 8 + head]; }
        const float il = 1.0f / ls; float ss = 0.f;
#pragma unroll
        for (int q = 0; q < 4; ++q) { a[q] = a[q] * il; ss += (a[q].x * a[q].x + a[q].y * a[q].y) + (a[q].z * a[q].z + a[q].w * a[q].w); }
        ss += shflx(ss, 1, lane); ss += shflx(ss, 2, lane); ss += shflx(ss, 4, lane);
        const float rstd = 1.0f / sqrtf(ss * (1.f / 128.f) + EPS);
        u32x4 r0, r1; const f32x4* gp = (const f32x4*)(bon + cb);
        f32x4 g0 = gp[0], g1 = gp[1], g2 = gp[2], g3 = gp[3];
        a[0] = a[0] * rstd * g0; a[1] = a[1] * rstd * g1; a[2] = a[2] * rstd * g2; a[3] = a[3] * rstd * g3;
        r0.x = pk2(a[0].x, a[0].y); r0.y = pk2(a[0].z, a[0].w); r0.z = pk2(a[1].x, a[1].y); r0.w = pk2(a[1].z, a[1].w);
        r1.x = pk2(a[2].x, a[2].y); r1.y = pk2(a[2].z, a[2].w); r1.z = pk2(a[3].x, a[3].y); r1.w = pk2(a[3].z, a[3].w);
        bf16* o = AO + (size_t)m * DM + 1024 + 16 * lane;
        *(u32x4*)o = r0; *(u32x4*)(o + 8) = r1;
    }
}

__device__ __forceinline__ void norm_router_phase(Frame& F, const bf16* X, const float* g, bf16* H, const float* router) {
    float* Rt = (float*)F.lds;
    int* cnt = (int*)(F.lds + 65536);
    for (int idx = F.tid; idx < DM * NE; idx += NTHR) { const int j = idx >> 3, e = idx & 7; Rt[e * DM + j] = router[idx]; }
    if (F.tid < 8) cnt[F.tid] = 0;
    __syncthreads();
    int* TKE = (int*)(F.ws + WS_TOK + TK_E); float* TKG = (float*)(F.ws + WS_TOK + TK_G);
    const int lane = F.lane;
    for (int i = 0; i < 8; ++i) {
        const int m = 64 * F.c + 8 * F.wave + i;
        f32x4 v[8]; rms_row<true, true>((const float*)(X + (size_t)m * DM), g, (bf16*)((unsigned char*)H + (size_t)m * DM), lane, v);
        float lg[8];
#pragma unroll
        for (int e = 0; e < 8; ++e) { float a = 0.f;
#pragma unroll
            for (int j = 0; j < 8; ++j) { const f32x4 r = *(const f32x4*)(Rt + e * DM + 256 * j + 4 * lane); a += (v[j].x * r.x + v[j].y * r.y) + (v[j].z * r.z + v[j].w * r.w); }
            lg[e] = wave_sum(a, lane); }
        int e0 = 0; float v0 = lg[0];
#pragma unroll
        for (int e = 1; e < 8; ++e) if (lg[e] > v0) { v0 = lg[e]; e0 = e; }
        int e1 = -1; float v1 = -3.0e38f;
#pragma unroll
        for (int e = 0; e < 8; ++e) if (e != e0 && lg[e] > v1) { v1 = lg[e]; e1 = e; }
        const float g0 = 1.0f / (1.0f + __expf(v1 - v0)), g1 = 1.0f - g0;
        if (lane == 0) { TKE[2 * m] = e0; TKE[2 * m + 1] = e1; TKG[2 * m] = g0; TKG[2 * m + 1] = g1; atomicAdd(&cnt[e0], 1); atomicAdd(&cnt[e1], 1); }
    }
    __syncthreads();
    if (F.tid < 8) ((int*)(F.ws + WS_TOK + TK_WGCNT))[F.c * 8 + F.tid] = cnt[F.tid];
    __syncthreads();
}

__device__ __forceinline__ void norm_router6_phase(Frame& F, const bf16* X, const float* g, unsigned char* H6, const float* router) {
    float* Rt = (float*)F.lds;
    int* cnt = (int*)(F.lds + 65536);
    for (int idx = F.tid; idx < DM * NE; idx += NTHR) { const int j = idx >> 3, e = idx & 7, l = j >> 5, i = j & 31; Rt[e * DM + ((i >> 2) * 64 + l) * 4 + (i & 3)] = router[idx]; }
    if (F.tid < 8) cnt[F.tid] = 0;
    __syncthreads();
    int* TKE = (int*)(F.ws + WS_TOK + TK_E); float* TKG = (float*)(F.ws + WS_TOK + TK_G);
    const int lane = F.lane;
    for (int i = 0; i < 8; ++i) {
        const int m = 64 * F.c + 8 * F.wave + i;
        float y[32]; rms_row6<true>((const void*)(X + (size_t)m * DM), g, H6 + (size_t)m * DM, lane, y);
        float lg[8];
#pragma unroll
        for (int e = 0; e < 8; ++e) { float a = 0.f;
#pragma unroll
            for (int q = 0; q < 8; ++q) { const f32x4 r = *(const f32x4*)(Rt + e * DM + (q * 64 + lane) * 4); a += (y[4 * q] * r.x + y[4 * q + 1] * r.y) + (y[4 * q + 2] * r.z + y[4 * q + 3] * r.w); }
            lg[e] = wave_sum(a, lane); }
        int e0 = 0; float v0 = lg[0];
#pragma unroll
        for (int e = 1; e < 8; ++e) if (lg[e] > v0) { v0 = lg[e]; e0 = e; }
        int e1 = -1; float v1 = -3.0e38f;
#pragma unroll
        for (int e = 0; e < 8; ++e) if (e != e0 && lg[e] > v1) { v1 = lg[e]; e1 = e; }
        const float g0 = 1.0f / (1.0f + __expf(v1 - v0)), g1 = 1.0f - g0;
        if (lane == 0) { TKE[2 * m] = e0; TKE[2 * m + 1] = e1; TKG[2 * m] = g0; TKG[2 * m + 1] = g1; atomicAdd(&cnt[e0], 1); atomicAdd(&cnt[e1], 1); }
    }
    __syncthreads();
    if (F.tid < 8) ((int*)(F.ws + WS_TOK + TK_WGCNT))[F.c * 8 + F.tid] = cnt[F.tid];
    __syncthreads();
}

__device__ __forceinline__ void moe_scatter_phase(Frame& F) {
    int* call = (int*)F.lds;
    int* tot = call + 2048; int* before = tot + 8; int* base = before + 8; int* pstart = base + 8; int* rowmap = pstart + 16;
    const int* WGC = (const int*)(F.ws + WS_TOK + TK_WGCNT);
    for (int idx = F.tid; idx < 2048; idx += NTHR) call[idx] = WGC[idx];
    __syncthreads();
    {
        const int e = F.wave, lane = F.lane; int t = 0, b = 0;
#pragma unroll
        for (int k = 0; k < 4; ++k) { const int w = lane + 64 * k; const int x = call[w * 8 + e]; t += x; b += (w < F.c) ? x : 0; }
#pragma unroll
        for (int o = 1; o < 64; o <<= 1) { t += __builtin_amdgcn_ds_bpermute((lane ^ o) << 2, t); b += __builtin_amdgcn_ds_bpermute((lane ^ o) << 2, b); }
        if (lane == 0) { tot[e] = t; before[e] = b; } }
    __syncthreads();
    if (F.tid == 0) { int ps = 0; for (int e = 0; e < 8; ++e) { pstart[e] = ps; base[e] = ps + before[e]; ps += ((tot[e] + 255) >> 8) << 8; } pstart[8] = ps;
        if (F.c == 0) { int* meta = (int*)(F.ws + WS_TOK + TK_META); for (int e = 0; e <= 8; ++e) meta[e] = pstart[e] >> 8; } }
    __syncthreads();
    const int* TKE = (const int*)(F.ws + WS_TOK + TK_E); int* TKP = (int*)(F.ws + WS_TOK + TK_POS);
    {
        const int e = F.wave, lane = F.lane, s0 = 64 * F.c * 2 + lane, s1 = s0 + 64;
        const bool f0 = TKE[s0] == e, f1 = TKE[s1] == e;
        const unsigned long long m0 = __builtin_amdgcn_ballot_w64(f0), m1 = __builtin_amdgcn_ballot_w64(f1), lt = (1ull << lane) - 1ull;
        const int r0 = base[e] + __builtin_popcountll(m0 & lt), r1 = base[e] + __builtin_popcountll(m0) + __builtin_popcountll(m1 & lt);
        if (f0) { rowmap[lane] = r0; TKP[s0] = r0; }
        if (f1) { rowmap[lane + 64] = r1; TKP[s1] = r1; } }
    __syncthreads();
    const bf16* H = (const bf16*)(F.ws + WS_H); bf16* XG = (bf16*)(F.ws + WS_XG);
    for (int a = F.wave * 16; a < F.wave * 16 + 16; ++a) {
        const int tok = 64 * F.c + (a >> 1), pos = rowmap[a];
        const u32x4* src = (const u32x4*)((const unsigned char*)H + (size_t)tok * DM) + F.lane; u32x4* dst = (u32x4*)((unsigned char*)XG + (size_t)pos * DM) + F.lane;
#pragma unroll
        for (int q = 0; q < 2; ++q) dst[64 * q] = src[64 * q];
    }
    for (int e = 0; e < 8; ++e) { const int r0 = pstart[e] + tot[e], r1 = pstart[e + 1];
        for (int r = r0 + F.wave; r < r1; r += NWAVES) if (((r & 255) % F.G) == F.c % 256) { u32x4* dst = (u32x4*)((unsigned char*)XG + (size_t)r * DM) + F.lane;
#pragma unroll
            for (int q = 0; q < 2; ++q) dst[64 * q] = (u32x4){0u, 0u, 0u, 0u}; } }
    __syncthreads();
}

__device__ __forceinline__ void moe_combine_phase(Frame& F) {
    const int gw = F.c * NWAVES + F.wave, NGW = F.G * NWAVES, lane = F.lane;
    const float* TKG = (const float*)(F.ws + WS_TOK + TK_G); const int* TKP = (const int*)(F.ws + WS_TOK + TK_POS);
    const bf16* YE = (const bf16*)(F.ws + WS_YE);
    for (int m = gw; m < S; m += NGW) {
        const float g0 = TKG[2 * m] * W8INV, g1 = TKG[2 * m + 1] * W8INV; const int p0 = TKP[2 * m], p1 = TKP[2 * m + 1];
        f32x4* xr = (f32x4*)(F.out + (size_t)m * DM) + lane; const u32x2* xb = (const u32x2*)((const bf16*)(F.ws + WS_XRB) + (size_t)m * DM) + lane;
        const u32x2* y0 = (const u32x2*)(YE + (size_t)p0 * DM) + lane; const u32x2* y1 = (const u32x2*)(YE + (size_t)p1 * DM) + lane;
#pragma unroll
        for (int j = 0; j < 8; ++j) { const u32x2 xw = xb[64 * j]; f32x4 x = {bflo(xw.x), bfhi(xw.x), bflo(xw.y), bfhi(xw.y)}; const u32x2 a = y0[64 * j], b = y1[64 * j];
            x.x += g0 * bflo(a.x) + g1 * bflo(b.x); x.y += g0 * bfhi(a.x) + g1 * bfhi(b.x); x.z += g0 * bflo(a.y) + g1 * bflo(b.y); x.w += g0 * bfhi(a.y) + g1 * bfhi(b.y);
            xr[64 * j] = x; }
    }
}
#ifndef ATT_SDEPTH
#define ATT_SDEPTH 1
#endif
constexpr int SDEPTH = ATT_SDEPTH;
#ifndef DIFF_PV8
#define DIFF_PV8 1
#endif
constexpr size_t SHM_V = 64 * 128 * 2, SHM_K = 64 * 128 * 2;
#define KSWZ(row, colB) ((row) * 256 + ((colB) ^ (((row) & 7) << 4)))
__device__ __forceinline__ int crow(int r, int hi) { return (r & 3) + 8 * (r >> 2) + 4 * hi; }
__device__ __forceinline__ int v_st(int k, int c) { const int kk = (k & ~0xC) | ((k & 4) << 1) | ((k & 8) >> 1); return ((kk >> 3) * 4 + (c >> 5)) * 512 + ((kk & 7) * 32 + (c & 31)) * 2; }
__device__ __forceinline__ int v_rd_base(int lane) { return ((lane & 3) << 3) | (((lane >> 2) & 3) << 6) | (((lane >> 4) & 1) << 5) | (((lane >> 5) & 1) << 8); }
constexpr int v_rd_off(int d0, int ks, int half) { return d0 * 512 + ks * 4096 + half * 2048; }
template <int OFF> __device__ __forceinline__ s16x4 tr_read(int vb) {
    s16x4 r; asm volatile("ds_read_b64_tr_b16 %0, %1 offset:%2" : "=&v"(r) : "v"(vb), "i"(OFF) : "memory"); return r;
}
template <int D0> __device__ __forceinline__ void pv_one(f32x16& od, int vb, bf16x8 pa0, bf16x8 pa1, bf16x8 pa2, bf16x8 pa3) {
    const s16x4 l0 = tr_read<v_rd_off(D0, 0, 0)>(vb), h0 = tr_read<v_rd_off(D0, 0, 1)>(vb), l1 = tr_read<v_rd_off(D0, 1, 0)>(vb), h1 = tr_read<v_rd_off(D0, 1, 1)>(vb);
    const s16x4 l2 = tr_read<v_rd_off(D0, 2, 0)>(vb), h2 = tr_read<v_rd_off(D0, 2, 1)>(vb), l3 = tr_read<v_rd_off(D0, 3, 0)>(vb), h3 = tr_read<v_rd_off(D0, 3, 1)>(vb);
    asm volatile("s_waitcnt lgkmcnt(0)" ::: "memory"); SBAR();
#define PK(L, H) (bf16x8){L[0], L[1], L[2], L[3], H[0], H[1], H[2], H[3]}
    od = __builtin_amdgcn_mfma_f32_32x32x16_bf16(pa0, PK(l0, h0), od, 0, 0, 0);
    od = __builtin_amdgcn_mfma_f32_32x32x16_bf16(pa1, PK(l1, h1), od, 0, 0, 0);
    od = __builtin_amdgcn_mfma_f32_32x32x16_bf16(pa2, PK(l2, h2), od, 0, 0, 0);
    od = __builtin_amdgcn_mfma_f32_32x32x16_bf16(pa3, PK(l3, h3), od, 0, 0, 0);
#undef PK
}
__device__ __forceinline__ void pv_d0(f32x16 (&o)[4], int vb, bf16x8 pa0, bf16x8 pa1, bf16x8 pa2, bf16x8 pa3) {
    pv_one<0>(o[0], vb, pa0, pa1, pa2, pa3); pv_one<1>(o[1], vb, pa0, pa1, pa2, pa3); pv_one<2>(o[2], vb, pa0, pa1, pa2, pa3); pv_one<3>(o[3], vb, pa0, pa1, pa2, pa3);
}
template <int NQ>
__device__ __forceinline__ void qkt(f32x16& p0, f32x16& p1, const char* Ks, const bf16x8 (&qr)[NQ], int r32, int hi, int kd0, float negb) {
    if (negb == 0.f) { p0 = f32x16{}; p1 = f32x16{}; }
    else {
#pragma unroll
        for (int r = 0; r < 16; ++r) { p0[r] = negb; p1[r] = negb; } }
#pragma unroll
    for (int d0 = 0; d0 < NQ; ++d0) { const int cb = (kd0 + d0 * 16 + hi * 8) * 2;
        const bf16x8 b0 = *reinterpret_cast<const bf16x8*>(Ks + KSWZ(r32, cb));
        const bf16x8 b1 = *reinterpret_cast<const bf16x8*>(Ks + KSWZ(32 + r32, cb));
        p0 = __builtin_amdgcn_mfma_f32_32x32x16_bf16(b0, qr[d0], p0, 0, 0, 0);
        p1 = __builtin_amdgcn_mfma_f32_32x32x16_bf16(b1, qr[d0], p1, 0, 0, 0); }
}
template <bool DIL>
__device__ __forceinline__ void sm_half(f32x16& p, int dbase, int mq, int L) {
#pragma unroll
    for (int r = 0; r < 16; ++r) { const float e = __builtin_amdgcn_exp2f(p[r]);
        if (DIL) { const int lo = (-mq > -64) ? -mq : -64, hi_ = (L - 1 - mq < 64) ? (L - 1 - mq) : 64;
            const bool ok = (unsigned)(dbase - lo + (r & 3) + 8 * (r >> 2)) <= (unsigned)(hi_ - lo); p[r] = ok ? e : 0.f; }
        else p[r] = e; }
}
__device__ __forceinline__ void sm_half_nomask(f32x16& p) {
#pragma unroll
    for (int r = 0; r < 16; ++r) p[r] = __builtin_amdgcn_exp2f(p[r]);
}
__device__ __forceinline__ void finish_sm(const f32x16& p0, const f32x16& p1, float& l_reg, bf16x8& pa0, bf16x8& pa1, bf16x8& pa2, bf16x8& pa3) {
    float ps = 0;
#pragma unroll
    for (int r = 0; r < 16; ++r) ps += p0[r];
#pragma unroll
    for (int r = 0; r < 16; ++r) ps += p1[r];
    { auto rr = __builtin_amdgcn_permlane32_swap(__float_as_uint(ps), __float_as_uint(ps), false, false);
      ps = __uint_as_float(rr[0]) + __uint_as_float(rr[1]); }
    l_reg += ps;
#define PK4(P, BASE, OUT) do { unsigned a0 = cvtpk(P[BASE + 0], P[BASE + 1]), a1 = cvtpk(P[BASE + 2], P[BASE + 3]);   \
    unsigned b0 = cvtpk(P[BASE + 4], P[BASE + 5]), b1 = cvtpk(P[BASE + 6], P[BASE + 7]);                              \
    auto r0 = __builtin_amdgcn_permlane32_swap(a0, b0, false, false); auto r1 = __builtin_amdgcn_permlane32_swap(a1, b1, false, false); \
    u32x4 w = {r0[0], r1[0], r0[1], r1[1]}; OUT = *reinterpret_cast<bf16x8*>(&w); } while (0)
    PK4(p0, 0, pa0); PK4(p0, 8, pa1); PK4(p1, 0, pa2); PK4(p1, 8, pa3);
#undef PK4
}

constexpr int SLOTB = 32768;
template <int NQ, bool DIL>
__device__ __forceinline__ void attn_core(const bf16* __restrict__ QKV, int dil, int res, int L, int mq0, int mk0, int NT, int kcol, int vcol, int kd0, float negb,
                                          const bf16x8 (&qr)[NQ], char* lds, f32x16 (&o)[4], float& l_reg, int tid) {
    asm volatile("" : "+v"(tid));
    const int lane = tid & 63, r32 = lane & 31, hi = lane >> 5, wv = __builtin_amdgcn_readfirstlane(tid >> 6);
    const int vbl = (int)(uintptr_t)lds + v_rd_base(lane);
    const int mq = mq0 + r32;
    const __amdgpu_buffer_rsrc_t rq = __builtin_amdgcn_make_buffer_rsrc((void*)QKV, 0, 0xffffffffu, 0x00020000);
    int rowK[2], colK[2], rowV[2], colV[2];
#pragma unroll
    for (int i = 0; i < 2; ++i) { const int q = 2 * wv + i;
        rowK[i] = 4 * q + (lane >> 4); colK[i] = kcol + 8 * ((lane & 15) ^ (rowK[i] & 7));
        const int sidx = 2 * q + (lane >> 5), piece = lane & 31, kk = (sidx >> 2) * 8 + (piece >> 2);
        rowV[i] = (kk & ~0xC) | ((kk & 4) << 1) | ((kk & 8) >> 1); colV[i] = vcol + (sidx & 3) * 32 + (piece & 3) * 8; }
    LAS unsigned char* ldsl = (LAS unsigned char*)(unsigned)(uintptr_t)lds;
#define VOFF(t, row, col) ({ int mk_ = mk0 + 64 * (t) + (row); if (DIL) mk_ = mk_ < 0 ? 0 : (mk_ > L - 1 ? L - 1 : mk_); (int)(((unsigned)(mk_ * dil + res) * (unsigned)QKVW + (unsigned)(col)) * 2u); })
    unsigned vofV[2], vofK[2];
#pragma unroll
    for (int i = 0; i < 2; ++i) { vofV[i] = ((unsigned)(rowV[i] * dil + res) * (unsigned)QKVW + (unsigned)colV[i]) * 2u; vofK[i] = ((unsigned)(rowK[i] * dil + res) * (unsigned)QKVW + (unsigned)colK[i]) * 2u; }
#define DMA(t) do { const int sb_ = ((t) & 3) * SLOTB; const int ml_ = mk0 + 64 * (t); \
        if (!DIL || (ml_ >= 0 && ml_ + 63 < L)) { const int so_ = (int)((unsigned)(ml_ * dil) * (unsigned)(QKVW * 2)); \
            _Pragma("unroll") for (int i_ = 0; i_ < 2; ++i_) { \
                __builtin_amdgcn_raw_ptr_buffer_load_lds(rq, (LAS unsigned*)(ldsl + sb_ + (2 * wv + i_) * 1024), 16, (int)vofV[i_], so_, 0, 0); \
                __builtin_amdgcn_raw_ptr_buffer_load_lds(rq, (LAS unsigned*)(ldsl + sb_ + 16384 + (2 * wv + i_) * 1024), 16, (int)vofK[i_], so_, 0, 0); } } \
        else { _Pragma("unroll") for (int i_ = 0; i_ < 2; ++i_) { \
            __builtin_amdgcn_raw_ptr_buffer_load_lds(rq, (LAS unsigned*)(ldsl + sb_ + (2 * wv + i_) * 1024), 16, VOFF(t, rowV[i_], colV[i_]), 0, 0, 0); \
            __builtin_amdgcn_raw_ptr_buffer_load_lds(rq, (LAS unsigned*)(ldsl + sb_ + 16384 + (2 * wv + i_) * 1024), 16, VOFF(t, rowK[i_], colK[i_]), 0, 0, 0); } } } while (0)
#define BAR() do { asm volatile("" ::: "memory"); __builtin_amdgcn_s_barrier(); asm volatile("" ::: "memory"); } while (0)
#define DB0(t) (mk0 + 64 * (t) + 4 * hi - mq)
#define ACT(t) (!DIL || ((mk0 + 64 * (t) + 63 >= mq0 - 64) && (mk0 + 64 * (t) <= mq0 + 31 + 64)))
#define FULLV(t, off) (DIL && (mk0 + 64 * (t) + (off) >= mq0 + 31 - 64) && (mk0 + 64 * (t) + (off) + 31 <= mq0 + 64) && (mk0 + 64 * (t) + (off) >= 0) && (mk0 + 64 * (t) + (off) + 31 < L))
#define SMH(P, t, off) do { if (FULLV(t, off)) sm_half_nomask(P); else sm_half<DIL>(P, DB0(t) + (off), mq, L); } while (0)
#define KS(t) (lds + ((t) & 3) * SLOTB + 16384)
#define VB(t) (vbl + ((t) & 3) * SLOTB)
    f32x16 pA0, pA1, pB0, pB1; bf16x8 pa0, pa1, pa2, pa3;
    DMA(0); DMA(1);
    asm volatile("s_waitcnt vmcnt(4)" ::: "memory"); BAR();
    if (2 < NT) DMA(2);
    if (ACT(0)) { qkt<NQ>(pA0, pA1, KS(0), qr, r32, hi, kd0, negb); SMH(pA0, 0, 0); }
    for (int j = 1; j + 1 < NT; j += 2) {
        asm volatile("s_waitcnt vmcnt(4)" ::: "memory"); BAR();
        DMA(j + 2);
        SBAR(); if (ACT(j)) qkt<NQ>(pB0, pB1, KS(j), qr, r32, hi, kd0, negb);
        if (ACT(j - 1)) { SMH(pA1, j - 1, 32); finish_sm(pA0, pA1, l_reg, pa0, pa1, pa2, pa3); } SBAR();
        if (ACT(j - 1)) pv_d0(o, VB(j - 1), pa0, pa1, pa2, pa3);
        if (ACT(j)) SMH(pB0, j, 0);
        if (j + 3 < NT) { asm volatile("s_waitcnt vmcnt(4)" ::: "memory"); } else { asm volatile("s_waitcnt vmcnt(0)" ::: "memory"); }
        BAR();
        if (j + 3 < NT) DMA(j + 3);
        SBAR(); if (ACT(j + 1)) qkt<NQ>(pA0, pA1, KS(j + 1), qr, r32, hi, kd0, negb);
        if (ACT(j)) { SMH(pB1, j, 32); finish_sm(pB0, pB1, l_reg, pa0, pa1, pa2, pa3); } SBAR();
        if (ACT(j)) pv_d0(o, VB(j), pa0, pa1, pa2, pa3);
        if (ACT(j + 1)) SMH(pA0, j + 1, 0);
    }
    asm volatile("s_waitcnt vmcnt(0)" ::: "memory"); BAR();
    SBAR(); if (ACT(NT - 1)) qkt<NQ>(pB0, pB1, KS(NT - 1), qr, r32, hi, kd0, negb);
    if (ACT(NT - 2)) { SMH(pA1, NT - 2, 32); finish_sm(pA0, pA1, l_reg, pa0, pa1, pa2, pa3); } SBAR();
    if (ACT(NT - 2)) pv_d0(o, VB(NT - 2), pa0, pa1, pa2, pa3);
    if (ACT(NT - 1)) { SMH(pB0, NT - 1, 0);
        SMH(pB1, NT - 1, 32); finish_sm(pB0, pB1, l_reg, pa0, pa1, pa2, pa3); } SBAR();
    if (ACT(NT - 1)) pv_d0(o, VB(NT - 1), pa0, pa1, pa2, pa3);
    __syncthreads();
#undef VOFF
#undef DMA
#undef BAR
#undef DB0
#undef FULLV
#undef SMH
#undef ACT
#undef KS
#undef VB
}


__device__ __forceinline__ int v8_key(int s) { const int g = s >> 5, q = s & 31; return q < 16 ? crow(q, g) : 32 + crow(q - 16, g); }
__device__ __forceinline__ void v8t_phase(Frame& F) {
    const int gw = F.c * NWAVES + F.wave, NGW = F.G * NWAVES, lane = F.lane;
    const bf16* QKV = (const bf16*)(F.ws + WS_QKV); unsigned char* V8T = (unsigned char*)(F.ws + WS_V8T);
    unsigned char* scr = (unsigned char*)(F.lds + F.wave * 16384);
    for (int u = gw; u < 8 * 256; u += NGW) {
        const int h = u & 7, tile = u >> 3;
        const bf16* row = QKV + (size_t)(64 * tile + lane) * QKVW + 2048 + h * 128;
        u32x4 w[16];
#pragma unroll
        for (int j = 0; j < 16; ++j) w[j] = *(const u32x4*)(row + 8 * j);
#pragma unroll
        for (int j = 0; j < 16; ++j) { unsigned* d = (unsigned*)(scr + lane * 132 + 8 * j);
            d[0] = pg8::pk4_fp8(bflo(w[j].x), bfhi(w[j].x), bflo(w[j].y), bfhi(w[j].y)); d[1] = pg8::pk4_fp8(bflo(w[j].z), bfhi(w[j].z), bflo(w[j].w), bfhi(w[j].w)); }
        LDS_WAIT(); asm volatile("" ::: "memory");
        unsigned lo[16], hi2[16];
#pragma unroll
        for (int j = 0; j < 16; ++j) { unsigned a = 0, b = 0;
#pragma unroll
            for (int q = 0; q < 4; ++q) { const unsigned short t = *(const unsigned short*)(scr + v8_key(4 * j + q) * 132 + 2 * lane); a |= (unsigned)(t & 0xff) << (8 * q); b |= (unsigned)(t >> 8) << (8 * q); }
            lo[j] = a; hi2[j] = b; }
        u32x4* dst = (u32x4*)(V8T + ((size_t)(h * 256 + tile) * 128 + 2 * lane) * 64);
#pragma unroll
        for (int q = 0; q < 4; ++q) { dst[q] = (u32x4){lo[4 * q], lo[4 * q + 1], lo[4 * q + 2], lo[4 * q + 3]}; dst[4 + q] = (u32x4){hi2[4 * q], hi2[4 * q + 1], hi2[4 * q + 2], hi2[4 * q + 3]}; }
        LDS_WAIT(); asm volatile("" ::: "memory");
    }
}
typedef int i32x8a __attribute__((ext_vector_type(8)));
typedef int i32x4a __attribute__((ext_vector_type(4)));
constexpr int SLOT8 = 24576;
#ifndef L_MFMA
#define L_MFMA 1
#endif
__device__ __forceinline__ int pk4_fp8_inplace(float a, float b, float c, float d) { int w = __builtin_bit_cast(int, a); w = __builtin_amdgcn_cvt_pk_fp8_f32(a, b, w, false); w = __builtin_amdgcn_cvt_pk_fp8_f32(c, d, w, true); return w; }
__device__ __forceinline__ void finish_sm8(const f32x16& p0, const f32x16& p1, float& l_reg, i32x8a& A8) {
#if !L_MFMA
    float ps = 0;
#pragma unroll
    for (int r = 0; r < 16; ++r) ps += p0[r];
#pragma unroll
    for (int r = 0; r < 16; ++r) ps += p1[r];
    l_reg += ps;
#endif
#pragma unroll
    for (int j = 0; j < 4; ++j) { A8[j] = pk4_fp8_inplace(p0[4 * j], p0[4 * j + 1], p0[4 * j + 2], p0[4 * j + 3]); A8[4 + j] = pk4_fp8_inplace(p1[4 * j], p1[4 * j + 1], p1[4 * j + 2], p1[4 * j + 3]); }
}
#if L_MFMA
#define PV8_NOP ""
#else
#define PV8_NOP "s_nop 1\n\t"
#endif
__device__ __forceinline__ void pv8(f32x16 (&o)[4], f32x16& ol, const i32x4a& ones, const LAS unsigned char* vb0, const LAS unsigned char* vb1, const i32x8a& A8) {
    i32x8a vf[4];
#pragma unroll
    for (int d = 0; d < 4; ++d) { const i32x4a x = *(const LAS i32x4a*)(vb0 + d * 2048), y = *(const LAS i32x4a*)(vb1 + d * 2048); vf[d] = __builtin_shufflevector(x, y, 0, 1, 2, 3, 4, 5, 6, 7); }
#if L_MFMA
    asm volatile("s_nop 1\n\tv_mfma_f32_32x32x64_f8f6f4 %0, %1, %2, %0 blgp:4" : "+v"(ol) : "v"(A8), "v"(ones));
#endif
#pragma unroll
    for (int d = 0; d < 4; ++d) asm volatile(PV8_NOP "v_mfma_f32_32x32x64_f8f6f4 %0, %1, %2, %0" : "+v"(o[d]) : "v"(A8), "v"(vf[d]));
}
template <int DUMMY = 0>
__device__ __forceinline__ void attn_core_diff8(const bf16* __restrict__ QKV, const unsigned char* __restrict__ V8Th, int mq0, int NT, int kcol, int kd0, float negb,
                                                const bf16x8 (&qr)[4], char* lds, f32x16 (&o)[4], f32x16& ol, float& l_reg, int tid) {
    asm volatile("" : "+v"(tid));
    i32x4a ones;
#pragma unroll
    for (int i = 0; i < 4; ++i) asm volatile("v_mov_b32 %0, 0x22222222" : "=v"(ones[i]));
    const int lane = tid & 63, r32 = lane & 31, hi = lane >> 5, wv = __builtin_amdgcn_readfirstlane(tid >> 6);
    const __amdgpu_buffer_rsrc_t rq = __builtin_amdgcn_make_buffer_rsrc((void*)QKV, 0, 0xffffffffu, 0x00020000);
    const __amdgpu_buffer_rsrc_t rv = __builtin_amdgcn_make_buffer_rsrc((void*)V8Th, 0, 0xffffffffu, 0x00020000);
    int rowK[2], colK[2];
#pragma unroll
    for (int i = 0; i < 2; ++i) { const int q = 2 * wv + i; rowK[i] = 4 * q + (lane >> 4); colK[i] = kcol + 8 * ((lane & 15) ^ (rowK[i] & 7)); }
    const int vcol = 16 * wv + (lane >> 2), voffV = vcol * 64 + 16 * ((lane & 3) ^ ((vcol >> 2) & 3));
    LAS unsigned char* ldsl = (LAS unsigned char*)(unsigned)(uintptr_t)lds;
    const int sw = (r32 >> 2) & 3;
    const LAS unsigned char* vr0 = ldsl + r32 * 64 + 16 * ((2 * hi) ^ sw); const LAS unsigned char* vr1 = ldsl + r32 * 64 + 16 * ((2 * hi + 1) ^ sw);
#define VOFFK(t, row, col) ((int)(((unsigned)(64 * (t) + (row)) * (unsigned)QKVW + (unsigned)(col)) * 2u))
#define DMA(t) do { const int sb_ = ((t) & 3) * SLOT8; \
        __builtin_amdgcn_raw_ptr_buffer_load_lds(rv, (LAS unsigned*)(ldsl + sb_ + wv * 1024), 16, voffV, (t) * 8192, 0, 0); \
        _Pragma("unroll") for (int i_ = 0; i_ < 2; ++i_) \
            __builtin_amdgcn_raw_ptr_buffer_load_lds(rq, (LAS unsigned*)(ldsl + sb_ + 8192 + (2 * wv + i_) * 1024), 16, VOFFK(t, rowK[i_], colK[i_]), 0, 0, 0); } while (0)
#define BAR() do { asm volatile("" ::: "memory"); __builtin_amdgcn_s_barrier(); asm volatile("" ::: "memory"); } while (0)
#define KS(t) (lds + ((t) & 3) * SLOT8 + 8192)
#define VB0(t) (vr0 + ((t) & 3) * SLOT8)
#define VB1(t) (vr1 + ((t) & 3) * SLOT8)
#define EXP16(P) do { _Pragma("unroll") for (int r_ = 0; r_ < 16; ++r_) P[r_] = __builtin_amdgcn_exp2f(P[r_]); } while (0)
    f32x16 pA0, pA1, pB0, pB1; i32x8a A8a, A8b = {0, 0, 0, 0, 0, 0, 0, 0};
#define KEEP(x) asm volatile("" :: "v"(x))
    DMA(0); DMA(1);
    asm volatile("s_waitcnt vmcnt(3)" ::: "memory"); BAR();
    if (2 < NT) DMA(2);
    qkt<4>(pA0, pA1, KS(0), qr, r32, hi, kd0, negb); EXP16(pA0);
    for (int j = 1; j + 1 < NT; j += 2) {
        asm volatile("s_waitcnt vmcnt(3)" ::: "memory"); BAR();
        DMA(j + 2);
        SBAR(); qkt<4>(pB0, pB1, KS(j), qr, r32, hi, kd0, negb);
        EXP16(pA1); finish_sm8(pA0, pA1, l_reg, A8a); KEEP(A8b); SBAR();
        pv8(o, ol, ones, VB0(j - 1), VB1(j - 1), A8a); EXP16(pB0);
        if (j + 3 < NT) { asm volatile("s_waitcnt vmcnt(3)" ::: "memory"); } else { asm volatile("s_waitcnt vmcnt(0)" ::: "memory"); }
        BAR();
        if (j + 3 < NT) DMA(j + 3);
        SBAR(); qkt<4>(pA0, pA1, KS(j + 1), qr, r32, hi, kd0, negb);
        EXP16(pB1); finish_sm8(pB0, pB1, l_reg, A8b); KEEP(A8a); SBAR();
        pv8(o, ol, ones, VB0(j), VB1(j), A8b); EXP16(pA0);
    }
    asm volatile("s_waitcnt vmcnt(0)" ::: "memory"); BAR();
    SBAR(); qkt<4>(pB0, pB1, KS(NT - 1), qr, r32, hi, kd0, negb);
    EXP16(pA1); finish_sm8(pA0, pA1, l_reg, A8a); KEEP(A8b); SBAR();
    pv8(o, ol, ones, VB0(NT - 2), VB1(NT - 2), A8a); EXP16(pB0);
    EXP16(pB1); finish_sm8(pB0, pB1, l_reg, A8b); KEEP(A8a); SBAR();
    pv8(o, ol, ones, VB0(NT - 1), VB1(NT - 1), A8b);
    asm volatile("s_nop 15\n\ts_nop 15" ::: "memory");
    __syncthreads();
#undef KEEP
#undef VOFFK
#undef DMA
#undef BAR
#undef KS
#undef VB0
#undef VB1
#undef EXP16
}

__device__ __forceinline__ void diff_unit(Frame& F, int h, int qb, float lam, float oscale, float negb, const float* __restrict__ og) {
    const bf16* QKV = (const bf16*)(F.ws + WS_QKV); bf16* AO = (bf16*)(F.ws + WS_AO);
    { unsigned z_; asm volatile("s_mov_b32 %0, 0" : "=s"(z_)); QKV += z_; AO += z_; }
    int lane = F.lane; asm volatile("" : "+v"(lane));
    const int r32 = lane & 31, hi = lane >> 5, map = F.wave >> 2, wq = F.wave & 3;
    const int mq0 = qb * 128 + wq * 32;
    bf16x8 qr[4];
    { const bf16* Qw = QKV + (size_t)(mq0 + r32) * QKVW + h * 128 + map * 64 + hi * 8;
#pragma unroll
      for (int d0 = 0; d0 < 4; ++d0) qr[d0] = *(const bf16x8*)(Qw + d0 * 16); }
    f32x16 o[4];
#pragma unroll
    for (int d = 0; d < 4; ++d)
#pragma unroll
        for (int r = 0; r < 16; ++r) o[d][r] = 0.f;
    float l_reg = 0.f;
    char* lds = (char*)F.lds;
#if DIFF_PV8
    f32x16 ol;
#pragma unroll
    for (int r = 0; r < 16; ++r) ol[r] = 0.f;
    attn_core_diff8<0>(QKV, (const unsigned char*)(F.ws + WS_V8T) + (size_t)h * 256 * 8192, mq0, S / 64, 1024 + h * 128, map * 64, negb, qr, lds, o, ol, l_reg, F.tid);
#else
    attn_core<4, false>(QKV, 1, 0, S, mq0, 0, S / 64, 1024 + h * 128, 2048 + h * 128, map * 64, negb, qr, lds, o, l_reg, F.tid);
#endif
    float* li_l = (float*)(lds + 65536) + F.wave * 64;
#if DIFF_PV8 && !L_MFMA
    { const auto rr = __builtin_amdgcn_permlane32_swap(__float_as_uint(l_reg), __float_as_uint(l_reg), false, false); l_reg = __uint_as_float(rr[0]) + __uint_as_float(rr[1]); }
#endif
#if !(DIFF_PV8 && L_MFMA)
    if (hi == 0) li_l[r32] = l_reg;
    LDS_WAIT();
#endif
    float* xch = (float*)lds;
#pragma unroll
    for (int r = 0; r < 16; ++r) {
#if DIFF_PV8 && L_MFMA
        const float rl = __builtin_amdgcn_rcpf(ol[r]);
#else
        const float rl = __builtin_amdgcn_rcpf(li_l[crow(r, hi)]);
#endif
#pragma unroll
        for (int d = 0; d < 4; ++d) o[d][r] *= rl; }
    if (map == 1) {
#pragma unroll
        for (int d = 0; d < 4; ++d)
#pragma unroll
            for (int r = 0; r < 16; ++r) xch[(d * 16 + r) * 256 + wq * 64 + lane] = o[d][r];
    }
    __syncthreads();
    if (map == 0) {
        float gv[4];
#pragma unroll
        for (int d = 0; d < 4; ++d) gv[d] = og[32 * d + r32] * oscale;
#pragma unroll
        for (int r = 0; r < 16; ++r) {
            float ss = 0.f;
#pragma unroll
            for (int d = 0; d < 4; ++d) { const float v = o[d][r] - lam * xch[(d * 16 + r) * 256 + wq * 64 + lane]; o[d][r] = v; ss += v * v; }
            ss += shflx(ss, 1, lane); ss += shflx(ss, 2, lane); ss += shflx(ss, 4, lane); ss += shflx(ss, 8, lane); ss += shflx(ss, 16, lane);
            const float rstd = 1.0f / sqrtf(ss * (1.f / 128.f) + EPS);
            bf16* orow = AO + (size_t)(mq0 + crow(r, hi)) * DM + h * 128 + r32;
#pragma unroll
            for (int d = 0; d < 4; ++d) orow[32 * d] = (bf16)f2bf(o[d][r] * rstd * gv[d]);
        }
    }
    __syncthreads();
}


#ifndef DIFF16
#define DIFF16 1
#endif
__device__ __forceinline__ int v16_gsw(int col) { return ((col >> 1) & 1) | (((col >> 3) & 1) ? 6 : 0); }
__device__ __forceinline__ void v8t16_phase(Frame& F) {
    const int gw = F.c * NWAVES + F.wave, NGW = F.G * NWAVES, lane = F.lane;
    const bf16* QKV = (const bf16*)(F.ws + WS_QKV); unsigned char* V8T = (unsigned char*)(F.ws + WS_V8T);
    unsigned char* scr = (unsigned char*)(F.lds + F.wave * 16384);
    for (int u = gw; u < 8 * 256; u += NGW) {
        const int h = u & 7, tile = u >> 3;
        const bf16* row = QKV + (size_t)(64 * tile + lane) * QKVW + 2048 + h * 128;
        u32x4 w[16];
#pragma unroll
        for (int j = 0; j < 16; ++j) w[j] = *(const u32x4*)(row + 8 * j);
#pragma unroll
        for (int j = 0; j < 16; ++j) { unsigned* d = (unsigned*)(scr + lane * 132 + 8 * j);
            d[0] = pg8::pk4_fp8(bflo(w[j].x), bfhi(w[j].x), bflo(w[j].y), bfhi(w[j].y)); d[1] = pg8::pk4_fp8(bflo(w[j].z), bfhi(w[j].z), bflo(w[j].w), bfhi(w[j].w)); }
        LDS_WAIT(); asm volatile("" ::: "memory");
        unsigned lo[16], hi2[16];
#pragma unroll
        for (int j = 0; j < 16; ++j) { unsigned a = 0, b = 0;
#pragma unroll
            for (int q = 0; q < 4; ++q) { const int key = 16 * (j & 3) + 4 * (j >> 2) + q;
                const unsigned short t = *(const unsigned short*)(scr + key * 132 + 2 * lane); a |= (unsigned)(t & 0xff) << (8 * q); b |= (unsigned)(t >> 8) << (8 * q); }
            lo[j] = a; hi2[j] = b; }
        unsigned char* dst = V8T + ((size_t)(h * 128 + (tile >> 1)) * 128 + 2 * lane) * 128 + 16 * (tile & 1);
#pragma unroll
        for (int q = 0; q < 4; ++q) { *(u32x4*)(dst + 32 * q) = (u32x4){lo[4 * q], lo[4 * q + 1], lo[4 * q + 2], lo[4 * q + 3]}; *(u32x4*)(dst + 128 + 32 * q) = (u32x4){hi2[4 * q], hi2[4 * q + 1], hi2[4 * q + 2], hi2[4 * q + 3]}; }
        LDS_WAIT(); asm volatile("" ::: "memory");
    }
}
constexpr int SLOT16 = 49152;
__device__ __forceinline__ void attn_core_diff16(const bf16* __restrict__ QKV, const unsigned char* __restrict__ V8Th, int NP, int kcol, int cmap, float negb,
                                                 const bf16x8 (&qr)[2][2], char* lds, f32x4 (&o)[2][8], f32x4 (&ol)[2], int tid) {
    asm volatile("" : "+v"(tid));
    const int lane = tid & 63, fr = lane & 15, fq = lane >> 4, wv = __builtin_amdgcn_readfirstlane(tid >> 6);
    const __amdgpu_buffer_rsrc_t rq = __builtin_amdgcn_make_buffer_rsrc((void*)QKV, 0, 0xffffffffu, 0x00020000);
    const __amdgpu_buffer_rsrc_t rv = __builtin_amdgcn_make_buffer_rsrc((void*)V8Th, 0, 0xffffffffu, 0x00020000);
    int rowK[2], colK[2], voffV[2], voffK[2];
#pragma unroll
    for (int i = 0; i < 2; ++i) { const int q = 2 * wv + i; rowK[i] = 4 * q + (lane >> 4); colK[i] = kcol + 8 * ((lane & 15) ^ (rowK[i] & 15));
        const int pc = q * 64 + lane, col = pc >> 3; voffV[i] = col * 128 + 16 * ((pc & 7) ^ v16_gsw(col)); voffK[i] = (rowK[i] * QKVW + colK[i]) * 2; }
    LAS unsigned char* ldsl = (LAS unsigned char*)(unsigned)(uintptr_t)lds;
    i32x4a ones;
#pragma unroll
    for (int i = 0; i < 4; ++i) asm volatile("v_mov_b32 %0, 0x22222222" : "=v"(ones[i]));
#define VOFFK(t, row, col) ((int)(((unsigned)(64 * (t) + (row)) * (unsigned)QKVW + (unsigned)(col)) * 2u))
#define DMA16(p) do { const int ks_ = ((p) & 1) * 32768, vs2_ = 65536 + (int)((unsigned)(p) % 3u) * 16384;        \
        _Pragma("unroll") for (int i_ = 0; i_ < 2; ++i_) { \
            __builtin_amdgcn_raw_ptr_buffer_load_lds(rv, (LAS unsigned*)(ldsl + vs2_ + (2 * wv + i_) * 1024), 16, voffV[i_], (p) * 16384, 0, 0); \
            __builtin_amdgcn_raw_ptr_buffer_load_lds(rq, (LAS unsigned*)(ldsl + ks_ + (2 * wv + i_) * 1024), 16, voffK[i_], (2 * (p)) * (64 * QKVW * 2), 0, 0);            \
            __builtin_amdgcn_raw_ptr_buffer_load_lds(rq, (LAS unsigned*)(ldsl + ks_ + 16384 + (2 * wv + i_) * 1024), 16, voffK[i_], (2 * (p) + 1) * (64 * QKVW * 2), 0, 0); } } while (0)
    const int kbase = fr * 256; const int kc0 = ((8 * cmap + fq) ^ fr) * 16, kc1 = ((8 * cmap + 4 + fq) ^ fr) * 16;
    const int vsw = ((fr >> 1) & 1);
    const int vg = vsw | ((fr >> 3) ? 6 : 0);
    const int vbase = fr * 128, vc0 = ((2 * fq) ^ vg) * 16, vc1 = ((2 * fq + 1) ^ vg) * 16;
    f32x4 sA[2][4], sB[2][4]; i32x8a AX[2], AY[2];
#define QK16(S, KSOFF) do { const LAS unsigned char* k0_ = ldsl + ((KSOFF) + kbase + kc0); const LAS unsigned char* k1_ = ldsl + ((KSOFF) + kbase + kc1);        \
        _Pragma("unroll") for (int kb = 0; kb < 4; ++kb) { \
            const bf16x8 a0 = *(const LAS bf16x8*)(k0_ + kb * 4096), a1 = *(const LAS bf16x8*)(k1_ + kb * 4096); \
            _Pragma("unroll") for (int qb = 0; qb < 2; ++qb) { S[qb][kb] = __builtin_amdgcn_mfma_f32_16x16x32_bf16(a0, qr[qb][0], (f32x4){negb, negb, negb, negb}, 0, 0, 0); \
                S[qb][kb] = __builtin_amdgcn_mfma_f32_16x16x32_bf16(a1, qr[qb][1], S[qb][kb], 0, 0, 0); } } } while (0)
#define EXPCH(S, T, KB, CUR) do { _Pragma("unroll") for (int qb = 0; qb < 2; ++qb) { _Pragma("unroll") for (int e = 0; e < 4; ++e) S[qb][KB][e] = __builtin_amdgcn_exp2f(S[qb][KB][e]); \
            CUR[qb][4 * (T) + (KB)] = pk4_fp8_inplace(S[qb][KB][0], S[qb][KB][1], S[qb][KB][2], S[qb][KB][3]); } } while (0)
#define LDV(VSB, CB) ({ const i32x4a x_ = *(const LAS i32x4a*)(v0p_ + (CB) * 2048), y_ = *(const LAS i32x4a*)(v1p_ + (CB) * 2048); \
            (i32x8a)__builtin_shufflevector(x_, y_, 0, 1, 2, 3, 4, 5, 6, 7); })
#define PVCB(PREV, VF, CB) do { _Pragma("unroll") for (int qb = 0; qb < 2; ++qb) asm volatile("v_mfma_f32_16x16x128_f8f6f4 %0, %1, %2, %0" : "+v"(o[qb][CB]) : "v"(PREV[qb]), "v"(VF)); } while (0)
#define ONES16(PREV) do { _Pragma("unroll") for (int qb = 0; qb < 2; ++qb) asm volatile("v_mfma_f32_16x16x128_f8f6f4 %0, %1, %2, %0 blgp:4" : "+v"(ol[qb]) : "v"(PREV[qb]), "v"(ones)); } while (0)
#define KOFF(p) (((p) & 1) * 32768)
#define VOFFS(p) (65536 + (int)((unsigned)(p) % 3u) * 16384)
#define GBAR() do { asm volatile("s_waitcnt vmcnt(0)" ::: "memory"); __builtin_amdgcn_s_barrier(); asm volatile("" ::: "memory"); } while (0)
#define ITER16(p, CUR, PREV) do { \
        GBAR();                                   \
        if ((p) + 1 < NP) DMA16((p) + 1); \
        { const int kb_ = KOFF(p); SBAR(); QK16(sA, kb_); QK16(sB, kb_ + 16384); SBAR(); } \
        { const int vs_ = VOFFS((p) - 1); const LAS unsigned char* v0p_ = ldsl + (vs_ + vbase + vc0); const LAS unsigned char* v1p_ = ldsl + (vs_ + vbase + vc1); i32x8a v0_ = LDV(vs_, 0), v1_; \
          ONES16(PREV); \
          v1_ = LDV(vs_, 1); PVCB(PREV, v0_, 0); EXPCH(sA, 0, 0, CUR); SBAR(); \
          v0_ = LDV(vs_, 2); PVCB(PREV, v1_, 1); EXPCH(sA, 0, 1, CUR); SBAR(); \
          v1_ = LDV(vs_, 3); PVCB(PREV, v0_, 2); EXPCH(sA, 0, 2, CUR); SBAR(); \
          v0_ = LDV(vs_, 4); PVCB(PREV, v1_, 3); EXPCH(sA, 0, 3, CUR); SBAR(); \
          v1_ = LDV(vs_, 5); PVCB(PREV, v0_, 4); EXPCH(sB, 1, 0, CUR); SBAR(); \
          v0_ = LDV(vs_, 6); PVCB(PREV, v1_, 5); EXPCH(sB, 1, 1, CUR); SBAR(); \
          v1_ = LDV(vs_, 7); PVCB(PREV, v0_, 6); EXPCH(sB, 1, 2, CUR); SBAR(); \
                             PVCB(PREV, v1_, 7); EXPCH(sB, 1, 3, CUR); SBAR(); } } while (0)
    DMA16(0);
    GBAR();
    if (1 < NP) DMA16(1);
    QK16(sA, KOFF(0)); QK16(sB, KOFF(0) + 16384);
    EXPCH(sA, 0, 0, AX); EXPCH(sA, 0, 1, AX); EXPCH(sA, 0, 2, AX); EXPCH(sA, 0, 3, AX); EXPCH(sB, 1, 0, AX); EXPCH(sB, 1, 1, AX); EXPCH(sB, 1, 2, AX); EXPCH(sB, 1, 3, AX);
    int p = 1;
    for (; p + 1 < NP; p += 2) { ITER16(p, AY, AX); ITER16(p + 1, AX, AY); }
    if (p < NP) { ITER16(p, AY, AX); }
    { const int vs_ = VOFFS(NP - 1); const LAS unsigned char* v0p_ = ldsl + (vs_ + vbase + vc0); const LAS unsigned char* v1p_ = ldsl + (vs_ + vbase + vc1);
      asm volatile("s_nop 1" ::: "memory");
      if ((NP & 1) == 0) { ONES16(AY);
#pragma unroll
          for (int cb = 0; cb < 8; ++cb) { const i32x8a vf = LDV(vs_, cb); PVCB(AY, vf, cb); } }
      else { ONES16(AX);
#pragma unroll
          for (int cb = 0; cb < 8; ++cb) { const i32x8a vf = LDV(vs_, cb); PVCB(AX, vf, cb); } } }
    asm volatile("s_nop 15\n\ts_nop 15" ::: "memory");
    __syncthreads();
#undef VOFFK
#undef DMA16
#undef QK16
#undef EXPCH
#undef LDV
#undef PVCB
#undef ONES16
#undef KOFF
#undef VOFFS
#undef GBAR
#undef ITER16
}
__device__ __forceinline__ void diff_unit16(Frame& F, int h, int qb_, float lam, float oscale, float negb, const float* __restrict__ og) {
    const bf16* QKV = (const bf16*)(F.ws + WS_QKV); bf16* AO = (bf16*)(F.ws + WS_AO);
    { unsigned z_; asm volatile("s_mov_b32 %0, 0" : "=s"(z_)); QKV += z_; AO += z_; }
    int lane = F.lane; asm volatile("" : "+v"(lane));
    const int fr = lane & 15, fq = lane >> 4, map = F.wave >> 2, wq = F.wave & 3;
    const int mq0 = qb_ * 128 + wq * 32;
    bf16x8 qr[2][2];
#pragma unroll
    for (int qb = 0; qb < 2; ++qb)
#pragma unroll
        for (int ks = 0; ks < 2; ++ks) qr[qb][ks] = *(const bf16x8*)(QKV + (size_t)(mq0 + 16 * qb + fr) * QKVW + h * 128 + map * 64 + 32 * ks + 8 * fq);
    f32x4 o[2][8], ol[2];
#pragma unroll
    for (int qb = 0; qb < 2; ++qb) { ol[qb] = (f32x4){0.f, 0.f, 0.f, 0.f};
#pragma unroll
        for (int cb = 0; cb < 8; ++cb) o[qb][cb] = (f32x4){0.f, 0.f, 0.f, 0.f}; }
    char* lds = (char*)F.lds;
    attn_core_diff16(QKV, (const unsigned char*)(F.ws + WS_V8T) + (size_t)h * 128 * 16384, S / 128, 1024 + h * 128, map, negb, qr, lds, o, ol, F.tid);
    float* xch = (float*)lds;
#pragma unroll
    for (int qb = 0; qb < 2; ++qb)
#pragma unroll
        for (int e = 0; e < 4; ++e) { const float rl = __builtin_amdgcn_rcpf(ol[qb][e]);
#pragma unroll
            for (int cb = 0; cb < 8; ++cb) o[qb][cb][e] *= rl; }
    if (map == 1) {
#pragma unroll
        for (int qb = 0; qb < 2; ++qb)
#pragma unroll
            for (int cb = 0; cb < 8; ++cb)
#pragma unroll
                for (int e = 0; e < 4; ++e) xch[((qb * 8 + cb) * 4 + e) * 256 + wq * 64 + lane] = o[qb][cb][e];
    }
    __syncthreads();
    if (map == 0) {
        float gv[8];
#pragma unroll
        for (int cb = 0; cb < 8; ++cb) gv[cb] = og[16 * cb + fr] * oscale;
#pragma unroll
        for (int qb = 0; qb < 2; ++qb)
#pragma unroll
            for (int e = 0; e < 4; ++e) {
                float ss = 0.f;
#pragma unroll
                for (int cb = 0; cb < 8; ++cb) { const float v = o[qb][cb][e] - lam * xch[((qb * 8 + cb) * 4 + e) * 256 + wq * 64 + lane]; o[qb][cb][e] = v; ss += v * v; }
                ss += shflx(ss, 1, lane); ss += shflx(ss, 2, lane); ss += shflx(ss, 4, lane); ss += shflx(ss, 8, lane);
                const float rstd = 1.0f / sqrtf(ss * (1.f / 128.f) + EPS);
                bf16* orow = AO + (size_t)(mq0 + 16 * qb + 4 * fq + e) * DM + h * 128 + fr;
#pragma unroll
                for (int cb = 0; cb < 8; ++cb) orow[16 * cb] = (bf16)f2bf(o[qb][cb][e] * rstd * gv[cb]);
            }
    }
    __syncthreads();
}

__device__ __forceinline__ void dil_unit(Frame& F, int b, int dil, int h, int res, int mblk, float negb) {
    const bf16* QKV = (const bf16*)(F.ws + WS_QKV);
    { unsigned z_; asm volatile("s_mov_b32 %0, 0" : "=s"(z_)); QKV += z_; }
    bf16* OP = (bf16*)(F.ws + WS_DILP) + (size_t)b * S * 1024; float* LP = (float*)(F.ws + WS_DILL) + (size_t)b * S * 8;
    int lane = F.lane; asm volatile("" : "+v"(lane));
    const int r32 = lane & 31, hi = lane >> 5;
    const int L = S / dil, m0 = mblk * 256, mq0 = m0 + 32 * F.wave;
    bf16x8 qr[8];
    { const bf16* Qw = QKV + ((size_t)(mq0 + r32) * dil + res) * QKVW + 3072 + h * 128 + hi * 8;
#pragma unroll
      for (int d0 = 0; d0 < 8; ++d0) qr[d0] = *(const bf16x8*)(Qw + d0 * 16); }
    f32x16 o[4];
#pragma unroll
    for (int d = 0; d < 4; ++d)
#pragma unroll
        for (int r = 0; r < 16; ++r) o[d][r] = 0.f;
    float l_reg = 0.f;
    attn_core<8, true>(QKV, dil, res, L, mq0, m0 - 64, 6, 4096 + h * 128, 5120 + h * 128, 0, negb, qr, (char*)F.lds, o, l_reg, F.tid);
    if (hi == 0) LP[((size_t)(mq0 + r32) * dil + res) * 8 + h] = l_reg;
#pragma unroll
    for (int r = 0; r < 16; ++r) { bf16* orow = OP + ((size_t)(mq0 + crow(r, hi)) * dil + res) * 1024 + h * 128 + r32;
#pragma unroll
        for (int d = 0; d < 4; ++d) orow[32 * d] = (bf16)f2bf(o[d][r]); }
}

__device__ __forceinline__ float vec_absmax(const float* g, int n, int lane) {
    float m = 0.f; for (int i = lane; i < n; i += 64) m = fmaxf(m, fabsf(g[i]));
#pragma unroll
    for (int o = 1; o < 64; o <<= 1) m = fmaxf(m, shflx(m, o, lane));
    return m;
}
#ifndef PHASE_SPLIT
#define PHASE_SPLIT 1
#endif
__device__ __forceinline__ void dil_units_phase(Frame& F) {
    const float negbB = 0.f;
#ifndef DIL_REP
#define DIL_REP 1
#endif
    for (int rep_ = 0; rep_ < DIL_REP; ++rep_)
    for (int u = F.c; u < 3 * 512; u += F.G) {
        const int b = u >> 9, idx = u & 511, h = idx & 7, rest = idx >> 3, dil = b == 0 ? 1 : (b == 1 ? 4 : 16), nb = 64 / dil;
        dil_unit(F, b, dil, h, rest / nb, rest % nb, negbB);
    }
}
__device__ __forceinline__ void attention_phase(Frame& F, int l) {
    const float* const* P = F.in + 1 + 17 * l;
    float a = 0.f, b = 0.f; { const int i = F.lane; a = P[4][i] * P[5][i]; b = P[6][i] * P[7][i]; }
    a = wave_sum(a, F.lane); b = wave_sum(b, F.lane);
    const float lam_init = l == 0 ? 0.2f : 0.35550906759096934f;
    const float lam = __builtin_bit_cast(float, __builtin_amdgcn_readfirstlane(__builtin_bit_cast(int, __expf(a) - __expf(b) + lam_init)));
#if DIFF_PV8
    const float negbA = __builtin_bit_cast(float, __builtin_amdgcn_readfirstlane(__builtin_bit_cast(int, 8.8f - (8.0f * LOG2E * 1.02f) * vec_absmax(P[2], 64, F.lane) * vec_absmax(P[3], 64, F.lane))));
#else
    const float negbA = 0.f;
#endif
#if DIFF16
    for (int u = F.c; u < 8 * 128; u += F.G) diff_unit16(F, u & 7, u >> 3, lam, 1.0f - lam_init, negbA, P[8]);
#else
    for (int u = F.c; u < 8 * 128; u += F.G) diff_unit(F, u & 7, u >> 3, lam, 1.0f - lam_init, negbA, P[8]);
#endif
#if !PHASE_SPLIT
    dil_units_phase(F);
#endif
}
#ifndef PHASE_MASK
#define PHASE_MASK 0x7ff
#endif
#define PH_ON(k) ((PHASE_MASK >> (k)) & 1)
#ifndef DUP_MASK
#define DUP_MASK 0
#endif
#ifndef DUP_LAYERS
#define DUP_LAYERS 3
#endif
#define DUP(k, l) ((((DUP_MASK) >> (k)) & 1) && (((DUP_LAYERS) >> (l)) & 1))
constexpr int N_PHASES = 21;
struct Args { const float* in[36]; float* out; unsigned char* ws; int ph_lo, ph_hi; };
__global__ void __launch_bounds__(NTHR, 2) fwd_kernel(Args args) {
    extern __shared__ __attribute__((aligned(16))) unsigned char lds[];
    Frame F;
    const int wave_s = __builtin_amdgcn_readfirstlane(threadIdx.x >> 6);
#define LANE_NOW() ({ int l_; asm volatile("v_mbcnt_lo_u32_b32 %0, -1, 0\n\tv_mbcnt_hi_u32_b32 %0, -1, %0" : "=v"(l_)); l_; })
    F.lds = lds; F.tid = wave_s * 64 + LANE_NOW(); F.lane = F.tid & 63; F.wave = wave_s;
    F.G = gridDim.x; F.c = blockIdx.x; F.in = args.in; F.out = args.out; F.ws = args.ws;
    unsigned char* ws = args.ws;
    volatile LAS unsigned* MISC = (volatile LAS unsigned*)((LAS unsigned char*)lds + MISC_OFF);
    if (F.tid < 64) MISC[F.tid] = 0u;
    __syncthreads();
#if MK_PER_PHASE
#define GRID_BAR() do { } while (0)
#else
    XcdBarrier bar = xcd_barrier_post((unsigned*)(ws + WS_CTL) + CW_BAR, MISC + 8, F.tid == 0);
#define GRID_BAR() do { unsigned zb_; asm volatile("s_mov_b32 %0, 0" : "=s"(zb_)); XcdBarrier b2_ = bar; b2_.bar += zb_; b2_.x = xb_xcc_id();     \
        xcd_barrier(b2_, (wave_s * 64 + LANE_NOW()) == 0); } while (0)
#endif
#if MK_PER_PHASE
    const int lo = args.ph_lo, hi = args.ph_hi;
#else
    constexpr int lo = 0, hi = N_PHASES;
#endif
#define IN(k) (lo <= (k) && (k) < hi)
#define FRESH() do { unsigned z_; asm volatile("s_mov_b32 %0, 0" : "=s"(z_)); ws = args.ws + z_; F.ws = ws; F.out = args.out + z_; int t_ = wave_s * 64 + LANE_NOW(); asm volatile("" : "+v"(t_)); F.tid = t_; F.lane = t_ & 63; F.wave = wave_s; } while (0)
#define SEAM(k) do { if (IN(k) && IN((k) + 1)) GRID_BAR(); } while (0)
    PG8_LAS unsigned char* glds = (PG8_LAS unsigned char*)lds;

    if (IN(0) && PH_ON(10)) { FRESH(); p0_prologue(F); if (DUP(10, 0)) { GRID_BAR(); FRESH(); p0_prologue(F); } } SEAM(0);

    for (int l = 0; l < 2; ++l) {
        const int pb = 1 + 10 * l;
        if (IN(pb + 0) && PH_ON(0)) for (int rep = 0; rep < (DUP(0, l) ? 2 : 1); ++rep) { if (rep) GRID_BAR(); FRESH();
            pg8::Gemm g{(const bf16*)(ws + WS_H), (const bf16*)(ws + WS_WIN) + (size_t)l * QKVW * DM, S, QKVW, DM}; pg8::StaticOrder So; So.init(S, QKVW, F.G, F.c);
            const float* cA_ = (const float*)(ws + WS_ROPE); const float* sA_ = cA_ + (size_t)S * 32; const float* cB_ = sA_ + (size_t)S * 32; const float* sB_ = cB_ + (size_t)S * 64;
            pg8::EpiQKV E{(bf16*)(ws + WS_QKV), QKVW, cA_, sA_, cB_, sB_, F.in[1 + 17 * l + 2], F.in[1 + 17 * l + 3], F.in[1 + 17 * l + 9], F.in[1 + 17 * l + 10],
                          (PG8_LAS float*)(glds + MISC_OFF + 1024), EPS, 0.125f * LOG2E, 0.08838834764831845f * LOG2E};
            pg8::gemm_phase<pg8::EpiQKV, pg8::StaticOrder, false>(glds, g, So, E, nullptr, F.tid);
        } SEAM(pb + 0);
#if DIFF_PV8
        if (IN(pb + 1) && PH_ON(1)) { FRESH(); if (DIFF16) v8t16_phase(F); else v8t_phase(F); if (PHASE_SPLIT) { __syncthreads(); dil_units_phase(F); } } SEAM(pb + 1);
#endif
        if (IN(pb + 2) && PH_ON(2)) for (int rep = 0; rep < (DUP(2, l) ? 2 : 1); ++rep) { if (rep) GRID_BAR(); FRESH(); attention_phase(F, l); if (PHASE_SPLIT) dil_combine_phase(F, l); } if (!PHASE_SPLIT) SEAM(pb + 2);
        if (IN(pb + 3) && PH_ON(3)) for (int rep = 0; rep < (DUP(3, l) ? 2 : 1); ++rep) { if (rep) GRID_BAR(); FRESH(); if (!PHASE_SPLIT || rep) dil_combine_phase(F, l); } SEAM(pb + 3);
        if (IN(pb + 4) && PH_ON(4)) for (int rep = 0; rep < (DUP(4, l) ? 2 : 1); ++rep) { if (rep) GRID_BAR(); FRESH();
            pg8::Gemm g{(const bf16*)(ws + WS_AO), (const bf16*)(ws + WS_WOUT) + (size_t)l * DM * DM, S, DM, DM}; pg8::StaticOrder So; So.init(S, DM, F.G, F.c);
            bf16* xrb = (bf16*)(ws + WS_XRB);
            if (l == 0) { pg8::EpiResB<true, false> E{xrb, (const void*)F.in[0], DM, 1.0f}; pg8::gemm_phase<pg8::EpiResB<true, false>, pg8::StaticOrder, false>(glds, g, So, E, nullptr, F.tid); }
            else { pg8::EpiResB<false, false> E{xrb, (const void*)xrb, DM, 1.0f}; pg8::gemm_phase<pg8::EpiResB<false, false>, pg8::StaticOrder, false>(glds, g, So, E, nullptr, F.tid); }
        } SEAM(pb + 4);
        if (IN(pb + 5) && PH_ON(5)) for (int rep = 0; rep < (DUP(5, l) ? 2 : 1); ++rep) { if (rep) GRID_BAR(); FRESH();
#if GU_FP6
            if (l == 0) norm6_phase<true>(F, (const void*)(ws + WS_XRB), F.in[14], (unsigned char*)(ws + WS_H));
            else norm_router6_phase(F, (const bf16*)(ws + WS_XRB), F.in[31], (unsigned char*)(ws + WS_H), F.in[32]);
#else
            if (l == 0) norm_phase<DENSE_GU_FP8 != 0, true>(F, (const void*)(ws + WS_XRB), F.in[14], (bf16*)(ws + WS_H));
            else norm_router_phase(F, (const bf16*)(ws + WS_XRB), F.in[31], (bf16*)(ws + WS_H), F.in[32]);
#endif
        } SEAM(pb + 5);
        if (IN(pb + 6) && PH_ON(6)) for (int rep = 0; rep < (DUP(6, l) ? 2 : 1); ++rep) { if (rep) GRID_BAR(); FRESH(); if (l == 1) moe_scatter_phase(F); } if (l == 1) SEAM(pb + 6);
        if (IN(pb + 7) && PH_ON(7)) for (int rep = 0; rep < (DUP(7, l) ? 2 : 1); ++rep) { if (rep) GRID_BAR(); FRESH();
            if (l == 0) {
#if DENSE_GU_FP8
                pg8::Gemm g{(const bf16*)(ws + WS_H), (const bf16*)(ws + WS_WGU), S, 2 * DFF, DM / 2}; pg8::StaticOrder So; So.init(S, 2 * DFF, F.G, F.c);
#if DENSE_DN_FP8
                pg8::EpiSwiGLU8<GU_FP6 == 0> E{(unsigned char*)(ws + WS_HID), DFF, 1 << 20, GU_FP6 ? 1.0f : W8INV};
                pg8::gemm_phase<pg8::EpiSwiGLU8<GU_FP6 == 0>, pg8::StaticOrder, false, true, GU_FP6 != 0>(glds, g, So, E, nullptr, F.tid);
#else
#error "fp8 gate/up with a bf16 down GEMM is not wired up"
#endif
#else
                pg8::Gemm g{(const bf16*)(ws + WS_H), (const bf16*)(ws + WS_WGU), S, 2 * DFF, DM}; pg8::StaticOrder So; So.init(S, 2 * DFF, F.G, F.c);
#if DENSE_DN_FP8
                pg8::EpiSwiGLU8<GU_FP6 == 0> E{(unsigned char*)(ws + WS_HID), DFF, 1 << 20, 1.0f};
                pg8::gemm_phase<pg8::EpiSwiGLU8<GU_FP6 == 0>, pg8::StaticOrder, false>(glds, g, So, E, nullptr, F.tid);
#else
                pg8::EpiSwiGLU E{(bf16*)(ws + WS_HID), DFF, 1 << 20};
                pg8::gemm_phase<pg8::EpiSwiGLU, pg8::StaticOrder, false>(glds, g, So, E, nullptr, F.tid);
#endif
#endif
            } else {
                const int* meta = (const int*)(ws + WS_TOK + TK_META);
                pg8::Gemm g{(const bf16*)(ws + WS_XG), (const bf16*)(ws + WS_MGU), MPAD_MAX, NE * 2 * DEXP, DM / 2}; pg8::MoeOrder Mo; Mo.init(meta, 2 * DEXP / 256, F.G, F.c);
                pg8::EpiSwiGLU8<GU_FP6 == 0> E{(unsigned char*)(ws + WS_HID), DEXP, 2 * DEXP / 256, GU_FP6 ? 1.0f : W8INV};
                pg8::gemm_phase<pg8::EpiSwiGLU8<GU_FP6 == 0>, pg8::MoeOrder, false, true, GU_FP6 != 0>(glds, g, Mo, E, nullptr, F.tid);
            }
        } SEAM(pb + 7);
        if (IN(pb + 8) && PH_ON(8)) for (int rep = 0; rep < (DUP(8, l) ? 2 : 1); ++rep) { if (rep) GRID_BAR(); FRESH();
            if (l == 0) {
#if DENSE_DN_FP8
                pg8::Gemm g{(const bf16*)(ws + WS_HID), (const bf16*)(ws + WS_WDN), S, DM, DFF / 2}; pg8::StaticOrder So; So.init(S, DM, F.G, F.c);
                pg8::EpiResB<false, true> E{(bf16*)(ws + WS_XRB), (const void*)(ws + WS_XRB), DM, W8INV};
                pg8::gemm_phase<pg8::EpiResB<false, true>, pg8::StaticOrder, false, true>(glds, g, So, E, nullptr, F.tid);
#else
                pg8::Gemm g{(const bf16*)(ws + WS_HID), (const bf16*)(ws + WS_WDN), S, DM, DFF}; pg8::StaticOrder So; So.init(S, DM, F.G, F.c);
                pg8::EpiResB<false, false> E{(bf16*)(ws + WS_XRB), (const void*)(ws + WS_XRB), DM, 1.0f};
                pg8::gemm_phase<pg8::EpiResB<false, false>, pg8::StaticOrder, false>(glds, g, So, E, nullptr, F.tid);
#endif
            } else {
                const int* meta = (const int*)(ws + WS_TOK + TK_META);
                pg8::Gemm g{(const bf16*)(ws + WS_HID), (const bf16*)(ws + WS_MDN), MPAD_MAX, NE * DM, DEXP / 2}; pg8::MoeOrder Mo; Mo.init(meta, DM / 256, F.G, F.c);
                pg8::EpiBf16 E{(bf16*)(ws + WS_YE), DM, DM / 256};
                pg8::gemm_phase<pg8::EpiBf16, pg8::MoeOrder, false, true>(glds, g, Mo, E, nullptr, F.tid);
            }
        } SEAM(pb + 8);
        if (IN(pb + 9) && PH_ON(9)) for (int rep = 0; rep < (DUP(9, l) ? 2 : 1); ++rep) { if (rep) GRID_BAR(); FRESH();
            if (l == 0) norm_phase<false, true>(F, (const void*)(ws + WS_XRB), F.in[18], (bf16*)(ws + WS_H));
            else moe_combine_phase(F);
        } SEAM(pb + 9);
    }
#undef IN
#undef SEAM
}

extern "C" void kernel_launch(void* const* d_in, const int* in_sizes, int n_in, void* d_out, int out_size, void* d_ws, size_t ws_size, hipStream_t stream) {
    static int grid = 0;
    if (grid == 0) {
        if (n_in != 36 || in_sizes[0] != S * DM || out_size != S * DM || ws_size < WS_END) {
            fprintf(stderr, "kernel_launch: shape mismatch: n_in %d in0 %d out %d ws %zu (need >= %zu)\n", n_in, n_in > 0 ? in_sizes[0] : -1, out_size, ws_size, (size_t)WS_END); grid = -1; return; }
        int dev = 0, cus = 0, per_cu = 0;
        if (hipGetDevice(&dev) != hipSuccess || hipDeviceGetAttribute(&cus, hipDeviceAttributeMultiprocessorCount, dev) != hipSuccess) { fprintf(stderr, "kernel_launch: device query failed\n"); grid = -1; return; }
        if (hipFuncSetAttribute((const void*)fwd_kernel, hipFuncAttributeMaxDynamicSharedMemorySize, LDS_BYTES) != hipSuccess) { fprintf(stderr, "kernel_launch: hipFuncSetAttribute failed\n"); grid = -1; return; }
        if (hipOccupancyMaxActiveBlocksPerMultiprocessor(&per_cu, (const void*)fwd_kernel, NTHR, LDS_BYTES) != hipSuccess || per_cu < 1)
            fprintf(stderr, "kernel_launch: note: occupancy query reports %d workgroups per CU\n", per_cu);
        (void)hipGetLastError();
        grid = cus;
        if (grid != 256) { fprintf(stderr, "kernel_launch: this kernel needs a 256-CU device (got %d)\n", cus); grid = -1; return; }
    }
    if (grid < 0) return;
    if (hipMemsetAsync((char*)d_ws + WS_CTL, 0, CTL_ZERO_BYTES, stream) != hipSuccess) { fprintf(stderr, "kernel_launch: memset failed\n"); return; }
    Args a{};
    for (int i = 0; i < 36; ++i) a.in[i] = (const float*)d_in[i];
    a.out = (float*)d_out; a.ws = (unsigned char*)d_ws;
#if MK_PER_PHASE
    for (int p = 0; p < N_PHASES; ++p) {
        if (p == 7) continue;
        a.ph_lo = p; a.ph_hi = p + 1;
        hipLaunchKernelGGL(fwd_kernel, dim3(grid), dim3(NTHR), LDS_BYTES, stream, a);
    }
#else
    a.ph_lo = 0; a.ph_hi = N_PHASES;
    hipLaunchKernelGGL(fwd_kernel, dim3(grid), dim3(NTHR), LDS_BYTES, stream, a);
#endif
    const hipError_t le = hipPeekAtLastError();
    if (le != hipSuccess) fprintf(stderr, "kernel_launch: launch failed: %s\n", hipGetErrorName(le));
}
```

```cpp
#include <hip/hip_runtime.h>
#include <cstdio>
#include <cstdint>

#ifndef MK_PER_PHASE
#define MK_PER_PHASE 0
#endif

#define LAS __attribute__((address_space(3)))
#define GAS __attribute__((address_space(1)))
typedef unsigned short bf16;
typedef short bf16x8 __attribute__((ext_vector_type(8)));
typedef short s16x4 __attribute__((ext_vector_type(4)));
typedef float f32x4 __attribute__((ext_vector_type(4)));
typedef float f32x2 __attribute__((ext_vector_type(2)));
typedef float f32x16 __attribute__((ext_vector_type(16)));
typedef unsigned u32x4 __attribute__((ext_vector_type(4)));
typedef unsigned u32x2 __attribute__((ext_vector_type(2)));

constexpr int S = 16384, DM = 2048, QKVW = 6144, DFF = 5632, NE = 8, DEXP = 7168;
constexpr int MPAD_MAX = 2 * S + NE * 256;
constexpr float EPS = 1e-6f;
constexpr float LOG2E = 1.4426950408889634f;

constexpr size_t MiB = 1u << 20;
constexpr size_t WS_CTL = 0, CTL_ZERO_BYTES = 1 * MiB;
constexpr size_t WS_WIN = 2 * MiB;
constexpr size_t WS_WOUT = 50 * MiB;
constexpr size_t WS_WGU = 66 * MiB;
constexpr size_t WS_WDN = 110 * MiB;
constexpr size_t WS_MGU = 132 * MiB;
constexpr size_t WS_MDN = 580 * MiB;
constexpr size_t WS_H = 804 * MiB;
constexpr size_t WS_AO = 868 * MiB;
constexpr size_t WS_ROPE = 932 * MiB;
constexpr size_t WS_TOK = 944 * MiB;
constexpr size_t WS_XG = 946 * MiB;
constexpr size_t WS_V8T = WS_XG + 80 * MiB;
constexpr size_t WS_YE = 1082 * MiB;
constexpr size_t WS_BIG = 1218 * MiB;
constexpr size_t WS_QKV = WS_BIG, WS_DILP = WS_BIG + 192 * MiB, WS_DILL = WS_DILP + 192 * MiB, WS_HID = WS_BIG;
constexpr size_t WS_XRB = WS_BIG + 476 * MiB;
constexpr size_t WS_END = WS_XRB + 64 * MiB;
constexpr size_t TK_E = 0, TK_G = (size_t)S * 2 * 4, TK_POS = (size_t)S * 4 * 4, TK_WGCNT = (size_t)S * 6 * 4, TK_META = TK_WGCNT + 256 * 8 * 4;
constexpr int CW_BAR = 4096;

__device__ __forceinline__ unsigned f2bf(float f) { unsigned u = __builtin_bit_cast(unsigned, f); return (u + 0x7fffu + ((u >> 16) & 1u)) >> 16; }
__device__ __forceinline__ unsigned pk2(float lo, float hi) { return f2bf(lo) | (f2bf(hi) << 16); }
__device__ __forceinline__ float bf2f(unsigned short b) { return __builtin_bit_cast(float, ((unsigned)b) << 16); }
__device__ __forceinline__ float bflo(unsigned w) { return __builtin_bit_cast(float, w << 16); }
__device__ __forceinline__ float bfhi(unsigned w) { return __builtin_bit_cast(float, w & 0xffff0000u); }
__device__ __forceinline__ unsigned cvtpk(float lo, float hi) { unsigned r; asm volatile("v_cvt_pk_bf16_f32 %0, %1, %2" : "=v"(r) : "v"(lo), "v"(hi)); return r; }
#define LDS_WAIT() asm volatile("s_waitcnt lgkmcnt(0)" ::: "memory")
#define VM_WAIT() asm volatile("s_waitcnt vmcnt(0)" ::: "memory")
#define SBAR() __builtin_amdgcn_sched_barrier(0)
__device__ __forceinline__ float shflx(float v, int o, int lane) { return __builtin_bit_cast(float, __builtin_amdgcn_ds_bpermute((lane ^ o) << 2, __builtin_bit_cast(int, v))); }
__device__ __forceinline__ float wave_sum(float v, int lane) {
#pragma unroll
    for (int o = 1; o < 64; o <<= 1) v += shflx(v, o, lane);
    return v;
}
namespace pg8 {
#define PG8_LAS __attribute__((address_space(3)))
typedef unsigned short bf16_t;
typedef short bf16x8 __attribute__((ext_vector_type(8)));
typedef float f32x4 __attribute__((ext_vector_type(4)));
typedef unsigned u32x4 __attribute__((ext_vector_type(4)));
typedef int i32x4 __attribute__((ext_vector_type(4)));
typedef int i32x8 __attribute__((ext_vector_type(8)));
typedef unsigned u32x2v __attribute__((ext_vector_type(2)));
constexpr int BM = 256, BK = 64, HALF = 128, HTB = HALF * BK * 2  , STAGE_BYTES = 8 * HTB, NXCD = 8, WGM = 8;

__host__ __device__ __forceinline__ int lds_byte(int r, int c) { const int st = (r >> 4) * 2 + (c >> 5), rr = r & 15, cc = c & 31, ob = rr * 64 + cc * 2; return st * 1024 + (ob ^ (((ob >> 9) & 1) << 5)); }
__host__ __device__ __forceinline__ void stage_rc(int b, int& R, int& C) { const int st = b / 1024, sb = b % 1024, swz = sb ^ (((sb >> 9) & 1) << 5); R = (st >> 1) * 16 + swz / 64; C = (st & 1) * 32 + (swz % 64) / 2; }
__host__ __device__ __forceinline__ int perm32(int rho) { const int n = rho >> 4, i = rho & 15; return 8 * (i >> 2) + 4 * n + (i & 3); }

struct Unit { int pm, pn; };
struct Gemm { const bf16_t* A; const bf16_t* Bt; int M, N, K; };

struct StaticOrder {
    int nM, nN, nwg, G, c;
    __host__ __device__ void init(int M, int N, int G_, int c_) { nM = M / BM; nN = N / BM; nwg = nM * nN; G = G_; c = c_; }
    __host__ __device__ bool next(int i, Unit& u) const {
        const long L = (long)i * G + c; if (L >= nwg) return false;
        int wgid = (int)L; { const int q = nwg / NXCD, r = nwg % NXCD, xcd = wgid % NXCD, off = wgid / NXCD; wgid = (xcd < r ? xcd * (q + 1) : r * (q + 1) + (xcd - r) * q) + off; }
        const int nig = WGM * nN, gid = wgid / nig, fm = gid * WGM, gsz = (nM - fm) < WGM ? (nM - fm) : WGM;
        u.pm = fm + ((wgid % nig) % gsz); u.pn = (wgid % nig) / gsz; return true;
    }
    __device__ __forceinline__ void a_ready(const Unit&) const {}
    __device__ __forceinline__ void done(const Unit&) const {}
};

struct MoeOrder {
    int ts0, ts1, ts2, ts3, ts4, ts5, ts6, ts7, ts8; int NT, nwg, G, c;
    __device__ void init(const int* tstart, int NT_, int G_, int c_) { ts0 = tstart[0]; ts1 = tstart[1]; ts2 = tstart[2]; ts3 = tstart[3]; ts4 = tstart[4]; ts5 = tstart[5]; ts6 = tstart[6]; ts7 = tstart[7]; ts8 = tstart[8];
        NT = NT_; nwg = ts8 * NT_; G = G_; c = c_; }
    __device__ bool next(int i, Unit& u) const {
        const long L = (long)i * G + c; if (L >= nwg) return false;
        int wgid = (int)L; { const int q = nwg / NXCD, r = nwg % NXCD, xcd = wgid % NXCD, off = wgid / NXCD; wgid = (xcd < r ? xcd * (q + 1) : r * (q + 1) + (xcd - r) * q) + off; }
        const int t = wgid / NT;
        int e = 0, lo = ts0, hi = ts1;
        if (t >= ts1) { e = 1; lo = ts1; hi = ts2; } if (t >= ts2) { e = 2; lo = ts2; hi = ts3; } if (t >= ts3) { e = 3; lo = ts3; hi = ts4; } if (t >= ts4) { e = 4; lo = ts4; hi = ts5; }
        if (t >= ts5) { e = 5; lo = ts5; hi = ts6; } if (t >= ts6) { e = 6; lo = ts6; hi = ts7; } if (t >= ts7) { e = 7; lo = ts7; hi = ts8; }
        const int Te = hi - lo, local = wgid - lo * NT;
        const int nig = WGM * NT, gid = local / nig, fm = gid * WGM, gsz = (Te - fm) < WGM ? (Te - fm) : WGM, rr = local % nig;
        u.pm = lo + fm + rr % gsz; u.pn = e * NT + rr / gsz; return true;
    }
    __device__ __forceinline__ void a_ready(const Unit&) const {}
    __device__ __forceinline__ void done(const Unit&) const {}
};

__device__ __forceinline__ unsigned cvt_pk_bf16(float lo, float hi) { unsigned r; asm volatile("v_cvt_pk_bf16_f32 %0, %1, %2" : "=v"(r) : "v"(lo), "v"(hi)); return r; }

struct EpiBf16 {
    static constexpr bool PERM = true, AFTER_DRAIN = false;
    bf16_t* O; int ldc; int ntn;
    __device__ __forceinline__ void operator()(const f32x4 (&acc)[2][2][4][2], const Unit& u, int wr, int wc, int fr, int fq) const {
        const int row0 = u.pm * BM + wr * 64 + fr; const int colt = (u.pn % ntn) * BM;
        const int col0 = colt + wc * 32 + 8 * fq;
#pragma unroll
        for (int ai = 0; ai < 2; ++ai)
#pragma unroll
            for (int m = 0; m < 4; ++m) { bf16_t* rowp = O + (size_t)(row0 + ai * HALF + m * 16) * ldc + col0;
#pragma unroll
                for (int bj = 0; bj < 2; ++bj) { const f32x4 v0 = acc[ai][bj][m][0], v1 = acc[ai][bj][m][1];
                    u32x4 w; w.x = cvt_pk_bf16(v0[0], v0[1]); w.y = cvt_pk_bf16(v0[2], v0[3]); w.z = cvt_pk_bf16(v1[0], v1[1]); w.w = cvt_pk_bf16(v1[2], v1[3]);
                    *(u32x4*)(rowp + bj * HALF) = w; } }
    }
};
template <bool SCALED>
struct EpiRes {
    static constexpr bool PERM = false, AFTER_DRAIN = false;
    float* C; const float* R; int ldc; float scale;
    __device__ __forceinline__ void operator()(const f32x4 (&acc)[2][2][4][2], const Unit& u, int wr, int wc, int fr, int fq) const {
        const int row0 = u.pm * BM + wr * 64 + fr, col0 = u.pn * BM + wc * 32 + 4 * fq;
        f32x4 cur[2][2], nxt[2][2];
#define ER_OFF(g_) ((size_t)(row0 + ((g_) >> 2) * HALF + ((g_) & 3) * 16) * ldc + col0)
#define ER_LOAD(dst, g_) do { const size_t o_ = ER_OFF(g_); _Pragma("unroll") for (int bj = 0; bj < 2; ++bj) _Pragma("unroll") for (int n = 0; n < 2; ++n) dst[bj][n] = *(const f32x4*)(R + o_ + bj * HALF + n * 16); } while (0)
        ER_LOAD(cur, 0);
#pragma unroll
        for (int g_ = 0; g_ < 8; ++g_) {
            if (g_ < 7) ER_LOAD(nxt, g_ + 1);
            const size_t off = ER_OFF(g_); const int ai = g_ >> 2, m = g_ & 3;
#pragma unroll
            for (int bj = 0; bj < 2; ++bj)
#pragma unroll
                for (int n = 0; n < 2; ++n) *(f32x4*)(C + off + bj * HALF + n * 16) = SCALED ? (acc[ai][bj][m][n] * scale + cur[bj][n]) : (acc[ai][bj][m][n] + cur[bj][n]);
#pragma unroll
            for (int bj = 0; bj < 2; ++bj)
#pragma unroll
                for (int n = 0; n < 2; ++n) cur[bj][n] = nxt[bj][n];
        }
#undef ER_OFF
#undef ER_LOAD
    }
};
template <bool RF32, bool SCALED>
struct EpiResB {
    static constexpr bool PERM = true, AFTER_DRAIN = false;
    bf16_t* C; const void* R; int ldc; float scale;
    __device__ __forceinline__ void operator()(const f32x4 (&acc)[2][2][4][2], const Unit& u, int wr, int wc, int fr, int fq) const {
        const int row0 = u.pm * BM + wr * 64 + fr, col0 = u.pn * BM + wc * 32 + 8 * fq;
        f32x4 cur[2][2], nxt[2][2];
#define EB_OFF(g_) ((size_t)(row0 + ((g_) >> 2) * HALF + ((g_) & 3) * 16) * ldc + col0)
#define EB_LOAD(dst, g_) do { const size_t o_ = EB_OFF(g_); _Pragma("unroll") for (int bj = 0; bj < 2; ++bj) { \
            if (RF32) { dst[bj][0] = *(const f32x4*)((const float*)R + o_ + bj * HALF); dst[bj][1] = *(const f32x4*)((const float*)R + o_ + bj * HALF + 4); } \
            else { const u32x4 w_ = *(const u32x4*)((const bf16_t*)R + o_ + bj * HALF); \
                dst[bj][0] = (f32x4){__builtin_bit_cast(float, w_.x << 16), __builtin_bit_cast(float, w_.x & 0xffff0000u), __builtin_bit_cast(float, w_.y << 16), __builtin_bit_cast(float, w_.y & 0xffff0000u)}; \
                dst[bj][1] = (f32x4){__builtin_bit_cast(float, w_.z << 16), __builtin_bit_cast(float, w_.z & 0xffff0000u), __builtin_bit_cast(float, w_.w << 16), __builtin_bit_cast(float, w_.w & 0xffff0000u)}; } } } while (0)
        EB_LOAD(cur, 0);
#pragma unroll
        for (int g_ = 0; g_ < 8; ++g_) {
            if (g_ < 7) EB_LOAD(nxt, g_ + 1);
            const size_t off = EB_OFF(g_); const int ai = g_ >> 2, m = g_ & 3;
#pragma unroll
            for (int bj = 0; bj < 2; ++bj) { const f32x4 v0 = SCALED ? (acc[ai][bj][m][0] * scale + cur[bj][0]) : (acc[ai][bj][m][0] + cur[bj][0]), v1 = SCALED ? (acc[ai][bj][m][1] * scale + cur[bj][1]) : (acc[ai][bj][m][1] + cur[bj][1]);
                u32x4 w; w.x = cvt_pk_bf16(v0[0], v0[1]); w.y = cvt_pk_bf16(v0[2], v0[3]); w.z = cvt_pk_bf16(v1[0], v1[1]); w.w = cvt_pk_bf16(v1[2], v1[3]);
                *(u32x4*)(C + off + bj * HALF) = w; }
#pragma unroll
            for (int bj = 0; bj < 2; ++bj)
#pragma unroll
                for (int n = 0; n < 2; ++n) cur[bj][n] = nxt[bj][n];
        }
#undef EB_OFF
#undef EB_LOAD
    }
};

__device__ __forceinline__ float silu_mul(float g, float u) { return g * u * __builtin_amdgcn_rcpf(1.0f + __builtin_amdgcn_exp2f(-1.4426950408889634f * g)); }
struct EpiSwiGLU {
    static constexpr bool PERM = true, AFTER_DRAIN = false;
    bf16_t* O; int ldh; int ntn;
    __device__ __forceinline__ void operator()(const f32x4 (&acc)[2][2][4][2], const Unit& u, int wr, int wc, int fr, int fq) const {
        const int row0 = u.pm * BM + wr * 64 + fr; const int col0 = (u.pn % ntn) * HALF + wc * 32 + 8 * fq;
#pragma unroll
        for (int ai = 0; ai < 2; ++ai)
#pragma unroll
            for (int m = 0; m < 4; ++m) { bf16_t* rowp = O + (size_t)(row0 + ai * HALF + m * 16) * ldh + col0;
                const f32x4 g0 = acc[ai][0][m][0], g1 = acc[ai][0][m][1], u0 = acc[ai][1][m][0], u1 = acc[ai][1][m][1];
                u32x4 w; w.x = cvt_pk_bf16(silu_mul(g0[0], u0[0]), silu_mul(g0[1], u0[1])); w.y = cvt_pk_bf16(silu_mul(g0[2], u0[2]), silu_mul(g0[3], u0[3]));
                w.z = cvt_pk_bf16(silu_mul(g1[0], u1[0]), silu_mul(g1[1], u1[1])); w.w = cvt_pk_bf16(silu_mul(g1[2], u1[2]), silu_mul(g1[3], u1[3]));
                *(u32x4*)rowp = w; }
    }
};

__device__ __forceinline__ unsigned pk4_fp8(float a, float b, float c, float d) { int w = 0; w = __builtin_amdgcn_cvt_pk_fp8_f32(a, b, w, false); w = __builtin_amdgcn_cvt_pk_fp8_f32(c, d, w, true); return (unsigned)w; }
template <bool SCALED = true>
struct EpiSwiGLU8 {
    static constexpr bool PERM = true, AFTER_DRAIN = false;
    unsigned char* O; int ldh; int ntn; float scale;
    __device__ __forceinline__ void operator()(const f32x4 (&acc)[2][2][4][2], const Unit& u, int wr, int wc, int fr, int fq) const {
        const int row0 = u.pm * BM + wr * 64 + fr; const int col0 = (u.pn % ntn) * HALF + wc * 32 + 8 * fq;
#pragma unroll
        for (int ai = 0; ai < 2; ++ai)
#pragma unroll
            for (int m = 0; m < 4; ++m) { unsigned char* rowp = O + (size_t)(row0 + ai * HALF + m * 16) * ldh + col0;
                const f32x4 g0 = SCALED ? acc[ai][0][m][0] * scale : acc[ai][0][m][0], g1 = SCALED ? acc[ai][0][m][1] * scale : acc[ai][0][m][1], u0 = SCALED ? acc[ai][1][m][0] * scale : acc[ai][1][m][0], u1 = SCALED ? acc[ai][1][m][1] * scale : acc[ai][1][m][1];
                u32x2v w; w.x = pk4_fp8(silu_mul(g0[0], u0[0]), silu_mul(g0[1], u0[1]), silu_mul(g0[2], u0[2]), silu_mul(g0[3], u0[3]));
                w.y = pk4_fp8(silu_mul(g1[0], u1[0]), silu_mul(g1[1], u1[1]), silu_mul(g1[2], u1[2]), silu_mul(g1[3], u1[3]));
                *(u32x2v*)rowp = w; }
    }
};

struct EpiQKV {
    static constexpr bool PERM = true, AFTER_DRAIN = false;
    bf16_t* O; int ldc;
    const float *cosA, *sinA, *cosB, *sinB;
    const float *dqn, *dkn, *bqn, *bkn;
    PG8_LAS float* xs;
    float eps, qsA, qsB;
    __device__ __forceinline__ static float xlane(float v, int o, int lane) { return __builtin_bit_cast(float, __builtin_amdgcn_ds_bpermute((lane ^ o) << 2, __builtin_bit_cast(int, v))); }
    __device__ __forceinline__ void operator()(const f32x4 (&acc)[2][2][4][2], const Unit& u, int wr, int wc, int fr, int fq) const {
        const int pn = u.pn, row0 = u.pm * BM + wr * 64 + fr, lane = fr + 16 * fq;
        if ((pn >= 8 && pn < 12) || pn >= 20) {
            const int col0 = pn * BM + wc * 32 + 8 * fq;
#pragma unroll
            for (int ai = 0; ai < 2; ++ai)
#pragma unroll
                for (int m = 0; m < 4; ++m) { bf16_t* rowp = O + (size_t)(row0 + ai * HALF + m * 16) * ldc + col0;
#pragma unroll
                    for (int bj = 0; bj < 2; ++bj) { const f32x4 v0 = acc[ai][bj][m][0], v1 = acc[ai][bj][m][1];
                        u32x4 w; w.x = cvt_pk_bf16(v0[0], v0[1]); w.y = cvt_pk_bf16(v0[2], v0[3]); w.z = cvt_pk_bf16(v1[0], v1[1]); w.w = cvt_pk_bf16(v1[2], v1[3]);
                        *(u32x4*)(rowp + bj * HALF) = w; } }
            return;
        }
        const bool grpA = pn < 8;
        const bool isq = grpA ? (pn < 4) : (pn < 16);
        const float* g_dq = dqn; const float* g_dk = dkn; const float* g_bq = bqn; const float* g_bk = bkn; const float q_a = qsA, q_b = qsB;
        const float* t_ca = cosA; const float* t_sa = sinA; const float* t_cb = cosB; const float* t_sb = sinB;
        asm volatile("" : "+s"(g_dq), "+s"(g_dk), "+s"(g_bq), "+s"(g_bk), "+s"(t_ca), "+s"(t_sa), "+s"(t_cb), "+s"(t_sb));
        const float* gain = grpA ? (isq ? g_dq : g_dk) : (isq ? g_bq : g_bk);
        const float qs = isq ? (grpA ? q_a : q_b) : 1.0f;
        const int w1 = wc & 1;
        const int gofs = grpA ? 8 * fq : 32 * w1 + 8 * fq;
        const int hd = grpA ? 32 : 64;
        const f32x4 ga0 = *(const f32x4*)(gain + gofs), ga1 = *(const f32x4*)(gain + gofs + 4), gb0 = *(const f32x4*)(gain + hd + gofs), gb1 = *(const f32x4*)(gain + hd + gofs + 4);
        float ssr[2][4];
#pragma unroll
        for (int ai = 0; ai < 2; ++ai)
#pragma unroll
            for (int m = 0; m < 4; ++m) { float ss = 0.f;
#pragma unroll
                for (int bj = 0; bj < 2; ++bj)
#pragma unroll
                    for (int n = 0; n < 2; ++n) { const f32x4 x = acc[ai][bj][m][n]; ss += (x[0] * x[0] + x[1] * x[1]) + (x[2] * x[2] + x[3] * x[3]); }
                ss += xlane(ss, 16, lane); ss += xlane(ss, 32, lane); ssr[ai][m] = ss; }
        if (!grpA) {
            PG8_LAS float* mine = xs + (wr * 4 + wc) * 128; const PG8_LAS float* other = xs + (wr * 4 + (wc ^ 1)) * 128;
            if (fq == 0) {
#pragma unroll
                for (int ai = 0; ai < 2; ++ai)
#pragma unroll
                    for (int m = 0; m < 4; ++m) mine[ai * 64 + m * 16 + fr] = ssr[ai][m]; }
            asm volatile("s_waitcnt lgkmcnt(0)" ::: "memory"); __builtin_amdgcn_s_barrier(); asm volatile("" ::: "memory");
#pragma unroll
            for (int ai = 0; ai < 2; ++ai)
#pragma unroll
                for (int m = 0; m < 4; ++m) ssr[ai][m] += other[ai * 64 + m * 16 + fr];
        }
        const float invd = grpA ? (1.0f / 64.0f) : (1.0f / 128.0f);
        const float* ct = grpA ? t_ca : t_cb; const float* st = grpA ? t_sa : t_sb;
        const int tw = grpA ? 32 : 64;
        const int col0 = pn * BM + (grpA ? 64 * wc + 8 * fq : 128 * (wc >> 1) + 32 * w1 + 8 * fq);
#pragma unroll
        for (int ai = 0; ai < 2; ++ai)
#pragma unroll
            for (int m = 0; m < 4; ++m) { const int row = row0 + ai * HALF + m * 16;
                const float rstd = qs * __builtin_amdgcn_rsqf(ssr[ai][m] * invd + eps);
                const float* cp = ct + (size_t)row * tw + gofs; const float* sp = st + (size_t)row * tw + gofs;
                const f32x4 c0 = *(const f32x4*)cp, c1 = *(const f32x4*)(cp + 4), s0 = *(const f32x4*)sp, s1 = *(const f32x4*)(sp + 4);
                const f32x4 ya0 = acc[ai][0][m][0] * rstd * ga0, ya1 = acc[ai][0][m][1] * rstd * ga1, yb0 = acc[ai][1][m][0] * rstd * gb0, yb1 = acc[ai][1][m][1] * rstd * gb1;
                const f32x4 oa0 = ya0 * c0 - yb0 * s0, oa1 = ya1 * c1 - yb1 * s1, ob0 = yb0 * c0 + ya0 * s0, ob1 = yb1 * c1 + ya1 * s1;
                bf16_t* rowp = O + (size_t)row * ldc + col0;
                u32x4 w; w.x = cvt_pk_bf16(oa0[0], oa0[1]); w.y = cvt_pk_bf16(oa0[2], oa0[3]); w.z = cvt_pk_bf16(oa1[0], oa1[1]); w.w = cvt_pk_bf16(oa1[2], oa1[3]);
                *(u32x4*)rowp = w;
                w.x = cvt_pk_bf16(ob0[0], ob0[1]); w.y = cvt_pk_bf16(ob0[2], ob0[3]); w.z = cvt_pk_bf16(ob1[0], ob1[1]); w.w = cvt_pk_bf16(ob1[2], ob1[3]);
                *(u32x4*)(rowp + hd) = w; }
    }
};

template <int MODE> struct FragT;
template <> struct FragT<0> { struct T { bf16x8 k0, k1; };
    static __device__ __forceinline__ void ld(T& d, const PG8_LAS unsigned char* p) { d.k0 = *(const PG8_LAS bf16x8*)p; d.k1 = *(const PG8_LAS bf16x8*)(p + 1024); }
    static __device__ __forceinline__ void mma(f32x4& c, const T& b, const T& a) { c = __builtin_amdgcn_mfma_f32_16x16x32_bf16(b.k0, a.k0, c, 0, 0, 0); c = __builtin_amdgcn_mfma_f32_16x16x32_bf16(b.k1, a.k1, c, 0, 0, 0); } };
template <> struct FragT<1> { typedef i32x8 T;
    static __device__ __forceinline__ void ld(T& d, const PG8_LAS unsigned char* p) { const i32x4 lo = *(const PG8_LAS i32x4*)p, hi = *(const PG8_LAS i32x4*)(p + 1024); d = __builtin_shufflevector(lo, hi, 0, 1, 2, 3, 4, 5, 6, 7); }
    static __device__ __forceinline__ void mma(f32x4& c, const T& b, const T& a) { asm volatile("s_nop 1\n\tv_mfma_f32_16x16x128_f8f6f4 %0, %1, %2, %0" : "+v"(c) : "v"(b), "v"(a)); } };

typedef int i32x6 __attribute__((ext_vector_type(6)));
template <> struct FragT<2> { typedef i32x8 T;
    static __device__ __forceinline__ void ld(T& d, const PG8_LAS unsigned char* p) { const i32x4 lo = *(const PG8_LAS i32x4*)p, hi = *(const PG8_LAS i32x4*)(p + 1024); d = __builtin_shufflevector(lo, hi, 0, 1, 2, 3, 4, 5, 6, 7); }
    static __device__ __forceinline__ void mma(f32x4& c, const T& b, const T& a) {
        const i32x6 b6 = __builtin_shufflevector(b, b, 0, 1, 2, 3, 4, 5), a6 = __builtin_shufflevector(a, a, 0, 1, 2, 3, 4, 5); const int sb = b[6], sa = a[6];
        asm volatile("s_nop 1\n\tv_mfma_scale_f32_16x16x128_f8f6f4 %0, %1, %2, %0, %3, %4 op_sel_hi:[0,0,0] cbsz:2 blgp:2" : "+v"(c) : "v"(b6), "v"(a6), "v"(sb), "v"(sa)); } };

template <class Epi, class Sched, bool STAMP = false, bool FP8 = false, bool FP6 = false>
__device__ __forceinline__ void gemm_phase(PG8_LAS unsigned char* lds, const Gemm g, const Sched& S, const Epi& E, unsigned long long* stamps, int tid) {
    asm volatile("" : "+v"(tid));
    const int wid = __builtin_amdgcn_readfirstlane(tid >> 6), lane = tid & 63, wr = wid >> 2, wc = wid & 3, fr = lane & 15, fq = lane >> 4;
    const int K = g.K, nt = K / BK;
    int ts_lo = 0, ts_hi = 0, nts = 0; const unsigned long long rt_entry = STAMP ? (unsigned long long)wall_clock64() : 0ull;
#define PG8_STAMP() do { if (STAMP && wid == 0 && nts < 64) { const unsigned long long _c = (unsigned long long)clock64(); \
        ts_lo = (lane == nts) ? (int)(unsigned)_c : ts_lo; ts_hi = (lane == nts) ? (int)(unsigned)(_c >> 32) : ts_hi; ++nts; } } while (0)
    PG8_STAMP();
    unsigned voffA[2], voffB[2];
#pragma unroll
    for (int i = 0; i < 2; ++i) { int R, C; stage_rc(tid * 16 + i * 8192, R, C); const int Rb = Epi::PERM ? ((R & ~31) + perm32(R & 31)) : R;
        voffA[i] = (unsigned)(R * K + C) * 2u; voffB[i] = (unsigned)(Rb * K + C) * 2u; }
    const unsigned kstep = (unsigned)(BK * 2);
    const unsigned hstep = (unsigned)HALF * K * 2;
    const unsigned tstep = 2 * hstep;
    const unsigned ldsw = (unsigned)wid * 1024u;
    const int aoff = lds_byte(wr * 64 + fr, fq * 8), boff = lds_byte(wc * 32 + fr, fq * 8);
#define PG8_SA(b, h) (((b) * 2 + (h)) * HTB)
#define PG8_SB(b, h) ((4 + (b) * 2 + (h)) * HTB)
    const __amdgpu_buffer_rsrc_t rA = __builtin_amdgcn_make_buffer_rsrc((void*)g.A, 0, 0xffffffffu, 0x00020000), rB = __builtin_amdgcn_make_buffer_rsrc((void*)g.Bt, 0, 0xffffffffu, 0x00020000);
#ifndef PG8_GLOBAL_STAGE
#define PG8_GLOBAL_STAGE 0
#endif
#define PG8_STAGE(rsrc, bufoff, gbase, voff) do { _Pragma("unroll") for (int _i = 0; _i < 2; ++_i) { \
        if (PG8_GLOBAL_STAGE && !FP8) __builtin_amdgcn_global_load_lds((const unsigned*)((&rsrc == &rA ? (const char*)g.A : (const char*)g.Bt) + (size_t)(gbase) + (voff)[_i]), (PG8_LAS unsigned*)(lds + (bufoff) + ldsw + _i * 8192), 16, 0, 0); \
        else __builtin_amdgcn_raw_ptr_buffer_load_lds(rsrc, (PG8_LAS unsigned*)(lds + (bufoff) + ldsw + _i * 8192), 16, (int)(voff)[_i], (int)(gbase), 0, 0); } } while (0)
#define PG8_LDA(dst, b, h) do { _Pragma("unroll") for (int m = 0; m < 4; ++m) FragT<FP8 ? (FP6 ? 2 : 1) : 0>::ld(dst[m], lds + PG8_SA(b, h) + aoff + m * 2048); } while (0)
#define PG8_LDB(dst, b, h) do { _Pragma("unroll") for (int n = 0; n < 2; ++n) FragT<FP8 ? (FP6 ? 2 : 1) : 0>::ld(dst[n], lds + PG8_SB(b, h) + boff + n * 2048); } while (0)
#define PG8_MMA(ai, bj, At, Bt) do { __builtin_amdgcn_s_setprio(1); _Pragma("unroll") for (int m = 0; m < 4; ++m) _Pragma("unroll") for (int n = 0; n < 2; ++n) \
        FragT<FP8 ? (FP6 ? 2 : 1) : 0>::mma(acc[ai][bj][m][n], Bt[n], At[m]); __builtin_amdgcn_s_setprio(0); } while (0)
#define PG8_WAIT_V(n) asm volatile("s_waitcnt vmcnt(" #n ")" ::: "memory")
#define PG8_WAIT_L(n) asm volatile("s_waitcnt lgkmcnt(" #n ")" ::: "memory")
#define PG8_BAR __builtin_amdgcn_s_barrier()
#define PG8_SCHED __builtin_amdgcn_sched_barrier(0)
    Unit cur, nxt; int ui = 0;
    if (!S.next(0, cur)) return;
    f32x4 acc[2][2][4][2];
#pragma unroll
    for (int a = 0; a < 2; ++a)
#pragma unroll
        for (int b = 0; b < 2; ++b)
#pragma unroll
            for (int m = 0; m < 4; ++m)
#pragma unroll
                for (int n = 0; n < 2; ++n) acc[a][b][m][n] = (f32x4){0.f, 0.f, 0.f, 0.f};
    typename FragT<FP8 ? (FP6 ? 2 : 1) : 0>::T At[4], B0[2], B1[2];
    unsigned cA = (unsigned)cur.pm * tstep, cB = (unsigned)cur.pn * tstep;
    S.a_ready(cur);
    PG8_STAGE(rB, PG8_SB(0, 0), cB, voffB); PG8_STAGE(rA, PG8_SA(0, 0), cA, voffA); PG8_STAGE(rB, PG8_SB(0, 1), cB + hstep, voffB); PG8_STAGE(rA, PG8_SA(0, 1), cA + hstep, voffA);
    if (wr == 1) PG8_BAR;
    PG8_WAIT_V(4); PG8_BAR;
    PG8_STAGE(rB, PG8_SB(1, 0), cB + kstep, voffB); PG8_STAGE(rA, PG8_SA(1, 0), cA + kstep, voffA); PG8_STAGE(rB, PG8_SB(1, 1), cB + hstep + kstep, voffB);
    PG8_WAIT_V(6); PG8_BAR;
    PG8_STAMP();
    for (;;) {
        const bool has_next = S.next(ui + 1, nxt);
        const unsigned nA = has_next ? (unsigned)nxt.pm * tstep : cA, nB = has_next ? (unsigned)nxt.pn * tstep : cB;
        for (int t = 0; t < nt; t += 2) {
            const bool last = (t == nt - 2);
            const unsigned a1 = cA + (unsigned)(t + 1) * kstep;
            const unsigned a2 = last ? nA : cA + (unsigned)(t + 2) * kstep, b2 = last ? nB : cB + (unsigned)(t + 2) * kstep;
            const unsigned a3 = a2 + kstep, b3 = b2 + kstep;
            if (last && has_next) S.a_ready(nxt);
            PG8_LDB(B0, 0, 0); PG8_SCHED; PG8_LDA(At, 0, 0); PG8_STAGE(rA, PG8_SA(1, 1), a1 + hstep, voffA);
            PG8_WAIT_L(8); PG8_BAR; PG8_WAIT_L(0); PG8_MMA(0, 0, At, B0); PG8_BAR; PG8_SCHED;
            PG8_LDB(B1, 0, 1); PG8_STAGE(rB, PG8_SB(0, 0), b2, voffB);
            PG8_BAR; PG8_WAIT_L(0); PG8_MMA(0, 1, At, B1); PG8_BAR;
            PG8_LDA(At, 0, 1); PG8_STAGE(rA, PG8_SA(0, 0), a2, voffA);
            PG8_BAR; PG8_WAIT_L(0); PG8_MMA(1, 0, At, B0); PG8_BAR; PG8_SCHED;
            PG8_STAGE(rB, PG8_SB(0, 1), b2 + hstep, voffB);
            PG8_WAIT_V(6); PG8_BAR; PG8_MMA(1, 1, At, B1); PG8_BAR;
            PG8_LDB(B0, 1, 0); PG8_SCHED; PG8_LDA(At, 1, 0); PG8_STAGE(rA, PG8_SA(0, 1), a2 + hstep, voffA);
            PG8_WAIT_L(8); PG8_BAR; PG8_WAIT_L(0); PG8_MMA(0, 0, At, B0); PG8_BAR; PG8_SCHED;
            PG8_LDB(B1, 1, 1); PG8_STAGE(rB, PG8_SB(1, 0), b3, voffB);
            PG8_BAR; PG8_WAIT_L(0); PG8_MMA(0, 1, At, B1); PG8_BAR;
            PG8_LDA(At, 1, 1); PG8_STAGE(rA, PG8_SA(1, 0), a3, voffA);
            PG8_BAR; PG8_WAIT_L(0); PG8_MMA(1, 0, At, B0); PG8_BAR; PG8_SCHED;
            PG8_STAGE(rB, PG8_SB(1, 1), b3 + hstep, voffB);
            PG8_WAIT_V(6); PG8_BAR; PG8_MMA(1, 1, At, B1); PG8_BAR;
        }
        PG8_STAMP();
        if constexpr (FP8) asm volatile("s_nop 15\n\ts_nop 15" ::: "memory");
        if constexpr (!Epi::AFTER_DRAIN) { int ln_; asm volatile("v_mbcnt_lo_u32_b32 %0, -1, 0\n\tv_mbcnt_hi_u32_b32 %0, -1, %0" : "=v"(ln_));
            E(acc, cur, wr, wc, ln_ & 15, ln_ >> 4); S.done(cur); }
        PG8_STAMP();
        if (!has_next) break;
#pragma unroll
        for (int a = 0; a < 2; ++a)
#pragma unroll
            for (int b = 0; b < 2; ++b)
#pragma unroll
                for (int m = 0; m < 4; ++m)
#pragma unroll
                    for (int n = 0; n < 2; ++n) acc[a][b][m][n] = (f32x4){0.f, 0.f, 0.f, 0.f};
        cur = nxt; cA = nA; cB = nB; ++ui;
    }
    PG8_WAIT_V(0);
    if (wr == 0) PG8_BAR;
    PG8_BAR;
    if constexpr (Epi::AFTER_DRAIN) { E.fused(acc, cur, wr, wc, fr, fq, lds, wid, lane); S.done(cur); }
    PG8_STAMP();
    if (STAMP && wid == 0) { stamps[lane] = lane < nts ? (((unsigned long long)(unsigned)ts_hi << 32) | (unsigned)ts_lo) : 0ull;
        if (lane == 62) stamps[62] = rt_entry; if (lane == 63) stamps[63] = (unsigned long long)wall_clock64(); }
#undef PG8_STAMP
#undef PG8_SA
#undef PG8_SB
#undef PG8_STAGE
#undef PG8_LDA
#undef PG8_LDB
#undef PG8_MMA
#undef PG8_WAIT_V
#undef PG8_WAIT_L
#undef PG8_BAR
#undef PG8_SCHED
}
}
#define XB_TMO      128
#define XB_XCNT(j)  (256  + 64 * (j))
#define XB_XSUB(j)  (1280 + 64 * (j))
#define XB_XGEN(j)  (2304 + 64 * (j))
#define XB_TOP      3328
#define XB_TOPGEN   3392
#define XCD_BAR_WORDS 3456
#define XB_SPIN_CAP (1u << 21)

__device__ __forceinline__ unsigned xb_ld(unsigned* p)              { return __hip_atomic_load(p, __ATOMIC_RELAXED, __HIP_MEMORY_SCOPE_AGENT); }
__device__ __forceinline__ unsigned xb_add(unsigned* p, unsigned v) { return __hip_atomic_fetch_add(p, v, __ATOMIC_RELAXED, __HIP_MEMORY_SCOPE_AGENT); }
__device__ __forceinline__ unsigned xb_xcc_id() { return (unsigned)__builtin_amdgcn_s_getreg((3 << 11) | 20) & 0xFu; }
#define XB_SPIN(cond, bar) do { unsigned _sp = 0; while (cond) { __builtin_amdgcn_s_sleep(1); \
    if ((++_sp & 255u) == 0u) { if (xb_ld(&(bar)[XB_TMO])) break; if (_sp > XB_SPIN_CAP) { atomicAdd(&(bar)[XB_TMO], 1u); break; } } } } while (0)

struct XcdBarrier {
    unsigned* bar; unsigned x;
    volatile LAS unsigned* st;
};

__device__ __forceinline__ XcdBarrier xcd_barrier_post(unsigned* bar, volatile LAS unsigned* st, bool is_t0) {
    XcdBarrier b; b.bar = bar; b.x = xb_xcc_id(); b.st = st;
    if (is_t0) (void)xb_add(&bar[XB_XCNT(b.x)], 1u);
    return b;
}
__device__ __forceinline__ void xcd_barrier_complete(unsigned* bar, unsigned x, unsigned& nloc, unsigned& nx) {
    const unsigned G = gridDim.x * gridDim.y * gridDim.z;
    unsigned sum, cnt, mine, sp = 0u;
    for (;;) {
        sum = 0u; cnt = 0u; mine = 0u;
#pragma unroll
        for (unsigned j = 0; j < 16; ++j) { const unsigned c = xb_ld(&bar[XB_XCNT(j)]); sum += c; cnt += (c > 0u) ? 1u : 0u; mine = (j == x) ? c : mine; }
        if (sum == G) break;
        __builtin_amdgcn_s_sleep(1);
        if ((++sp & 255u) == 0u) { if (xb_ld(&bar[XB_TMO])) break; if (sp > XB_SPIN_CAP) { atomicAdd(&bar[XB_TMO], 1u); break; } }
    }
    nloc = mine > 0u ? mine : 1u; nx = cnt > 0u ? cnt : 1u;
}

__device__ __forceinline__ void xcd_barrier(const XcdBarrier& b, bool is_t0) {
    asm volatile("s_waitcnt vmcnt(0)" ::: "memory");
    __syncthreads();
    if (is_t0) {
        unsigned* bar = b.bar;
        __builtin_amdgcn_s_waitcnt(0);
        unsigned nloc = b.st[0], nx = b.st[1];
        if (nloc == 0u) { xcd_barrier_complete(bar, b.x, nloc, nx); b.st[0] = nloc; b.st[1] = nx; }
        const unsigned old = xb_add(&bar[XB_XSUB(b.x)], 1u);
        const unsigned gen = old / nloc;
        if (old + 1u == (gen + 1u) * nloc) {
            __builtin_amdgcn_fence(__ATOMIC_RELEASE, "agent");
            asm volatile("s_waitcnt vmcnt(0)" ::: "memory");
            const unsigned og = xb_add(&bar[XB_TOP], 1u);
            const unsigned tg = og / nx;
            if (og + 1u == (tg + 1u) * nx) xb_add(&bar[XB_TOPGEN], 1u);
            else XB_SPIN(xb_ld(&bar[XB_TOPGEN]) == tg, bar);
            __builtin_amdgcn_fence(__ATOMIC_ACQUIRE, "agent");
            xb_add(&bar[XB_XGEN(b.x)], 1u);
            asm volatile("s_waitcnt vmcnt(0)" ::: "memory");
        } else {
            XB_SPIN(xb_ld(&bar[XB_XGEN(b.x)]) == gen, bar);
            __builtin_amdgcn_fence(__ATOMIC_ACQUIRE, "agent");
            asm volatile("s_waitcnt vmcnt(0)" ::: "memory");
        }
    }
    __syncthreads();
}

#ifndef DENSE_GU_FP8
#define DENSE_GU_FP8 1
#endif
#ifndef DENSE_DN_FP8
#define DENSE_DN_FP8 1
#endif
constexpr int NWAVES = 8, NTHR = 512;
constexpr float W8SCALE = 64.0f, W8INV = 1.0f / 64.0f;
constexpr int RING_BYTES = 131072;
constexpr int MISC_OFF = RING_BYTES;
constexpr int LDS_BYTES = 147456;

struct Frame {
    unsigned char* lds;
    int tid, lane, wave, G, c;
    const float* const* in;
    float* out; unsigned char* ws;
};

__device__ __forceinline__ int win_row(int c) {
    const int pn = c >> 8, r = c & 255, t = r & 31;
    if (pn < 8) return (pn << 8) + 128 * ((r >> 5) & 1) + 32 * (r >> 6) + t;
    if (pn >= 12 && pn < 20) return (pn << 8) + 128 * ((r >> 6) & 1) + 32 * (2 * (r >> 7) + ((r >> 5) & 1)) + t;
    return c;
}
template <bool GU, bool WIN = false>
__device__ __forceinline__ void tr_item(const float* __restrict__ W, int K, int N, bf16* __restrict__ WT, int upoff, float* scr, int item, int lane) {
    const int nblk = N / 32, kb = item / nblk, nb = item % nblk, k0 = 64 * kb, n0 = 32 * nb;
    float v[32];
#pragma unroll
    for (int i = 0; i < 32; ++i) { const int kk = 2 * i + (lane >> 5); v[i] = __builtin_nontemporal_load(W + (size_t)(k0 + kk) * N + n0 + (lane & 31)); }
#pragma unroll
    for (int i = 0; i < 32; ++i) { const int kk = 2 * i + (lane >> 5); scr[kk * 33 + (lane & 31)] = v[i]; }
    LDS_WAIT(); asm volatile("" ::: "memory");
    const int c = lane & 7;
#pragma unroll
    for (int j = 0; j < 4; ++j) { const int n = (lane >> 3) + 8 * j; const float* s = scr + (8 * c) * 33 + n;
        u32x4 o; o.x = pk2(s[0 * 33], s[1 * 33]); o.y = pk2(s[2 * 33], s[3 * 33]); o.z = pk2(s[4 * 33], s[5 * 33]); o.w = pk2(s[6 * 33], s[7 * 33]);
        const int np = n0 + n; const int orow = GU ? (((np >> 7) << 8) + (np & 127) + upoff) : (WIN ? win_row(np) : np);
        *(u32x4*)(WT + (size_t)orow * K + k0 + 8 * c) = o; }
    LDS_WAIT(); asm volatile("" ::: "memory");
}

template <bool GU>
__device__ __forceinline__ void tr_item8(const float* __restrict__ W, int K, int N, unsigned char* __restrict__ WT, int upoff, float wscale, float* scr, int item, int lane) {
    const int nblk = N / 32, kb = item / nblk, nb = item % nblk, k0 = 64 * kb, n0 = 32 * nb;
    float v[32];
#pragma unroll
    for (int i = 0; i < 32; ++i) { const int kk = 2 * i + (lane >> 5); v[i] = __builtin_nontemporal_load(W + (size_t)(k0 + kk) * N + n0 + (lane & 31)); }
#pragma unroll
    for (int i = 0; i < 32; ++i) { const int kk = 2 * i + (lane >> 5); scr[kk * 33 + (lane & 31)] = v[i] * wscale; }
    LDS_WAIT(); asm volatile("" ::: "memory");
    const int c = lane & 3;
#pragma unroll
    for (int j = 0; j < 2; ++j) { const int n = (lane >> 2) + 16 * j; const float* s = scr + (16 * c) * 33 + n;
        u32x4 o; o.x = pg8::pk4_fp8(s[0 * 33], s[1 * 33], s[2 * 33], s[3 * 33]); o.y = pg8::pk4_fp8(s[4 * 33], s[5 * 33], s[6 * 33], s[7 * 33]);
        o.z = pg8::pk4_fp8(s[8 * 33], s[9 * 33], s[10 * 33], s[11 * 33]); o.w = pg8::pk4_fp8(s[12 * 33], s[13 * 33], s[14 * 33], s[15 * 33]);
        const int np = n0 + n; const int orow = GU ? (((np >> 7) << 8) + (np & 127) + upoff) : np;
        *(u32x4*)(WT + (size_t)orow * K + k0 + 16 * c) = o; }
    LDS_WAIT(); asm volatile("" ::: "memory");
}

#ifndef GU_FP6
#define GU_FP6 1
#endif
typedef unsigned u32x6 __attribute__((ext_vector_type(6)));
__device__ __forceinline__ void mx6_block(const float (&x)[32], u32x4& p0, u32x4& p1) {
    float m = 0.f;
#pragma unroll
    for (int i = 0; i < 32; ++i) m = fmaxf(m, fabsf(x[i]));
    const unsigned mb = __builtin_bit_cast(unsigned, m);
    int ex = (int)((mb >> 23) & 255u) - 126;
    const unsigned fb = (mb & 0x007fffffu) | 0x3f000000u;
    int e = ex - 3 + ((__builtin_bit_cast(float, fb) > 0.9375f) ? 1 : 0);
    e = e < -126 ? -126 : e;
    const float scale = __builtin_bit_cast(float, (unsigned)(e + 127) << 23);
    f32x16 a, b;
#pragma unroll
    for (int i = 0; i < 16; ++i) { a[i] = x[i]; b[i] = x[16 + i]; }
    u32x6 d;
    asm volatile("v_cvt_scalef32_2xpk16_fp6_f32 %0, %1, %2, %3" : "=&v"(d) : "v"(a), "v"(b), "v"(scale));
    p0 = (u32x4){d[0], d[1], d[2], d[3]}; p1 = (u32x4){d[4], d[5], (unsigned)(e + 127), 0u};
}
__device__ __forceinline__ int mx6_off(int kb32) { return (kb32 >> 2) * 128 + (kb32 & 3) * 16; }
__device__ __forceinline__ void tr6_finish(const float (&v)[32], int K, unsigned char* __restrict__ WT, bool gu, int upoff, float* scr, int kb, int nb, int lane) {
    const int k0 = 64 * kb, n0 = 32 * nb;
#pragma unroll
    for (int i = 0; i < 32; ++i) { const int kk = 2 * i + (lane >> 5); scr[kk * 33 + (lane & 31)] = v[i]; }
    LDS_WAIT(); asm volatile("" ::: "memory");
    const int n = lane & 31, half = lane >> 5;
    float x[32];
#pragma unroll
    for (int i = 0; i < 32; ++i) x[i] = scr[(32 * half + i) * 33 + n];
    u32x4 p0, p1; mx6_block(x, p0, p1);
    const int np = n0 + n; const int orow = gu ? (((np >> 7) << 8) + (np & 127) + upoff) : np;
    unsigned char* dst = WT + (size_t)orow * K + mx6_off((k0 >> 5) + half);
    *(u32x4*)dst = p0; *(u32x4*)(dst + 64) = p1;
    LDS_WAIT(); asm volatile("" ::: "memory");
}

__device__ __forceinline__ void tr8_load(float (&v)[32], const float* __restrict__ W, int N, int kb, int nb, int lane) {
    const int k0 = 64 * kb, n0 = 32 * nb;
#pragma unroll
    for (int i = 0; i < 32; ++i) { const int kk = 2 * i + (lane >> 5); v[i] = __builtin_nontemporal_load(W + (size_t)(k0 + kk) * N + n0 + (lane & 31)); }
}
__device__ __forceinline__ void tr8_finish(const float (&v)[32], int K, int N, unsigned char* __restrict__ WT, bool gu, int upoff, float wscale, float* scr, int kb, int nb, int lane) {
    const int k0 = 64 * kb, n0 = 32 * nb;
#pragma unroll
    for (int i = 0; i < 32; ++i) { const int kk = 2 * i + (lane >> 5); scr[kk * 33 + (lane & 31)] = v[i] * wscale; }
    LDS_WAIT(); asm volatile("" ::: "memory");
    const int c = lane & 3;
#pragma unroll
    for (int j = 0; j < 2; ++j) { const int n = (lane >> 2) + 16 * j; const float* s = scr + (16 * c) * 33 + n;
        u32x4 o; o.x = pg8::pk4_fp8(s[0 * 33], s[1 * 33], s[2 * 33], s[3 * 33]); o.y = pg8::pk4_fp8(s[4 * 33], s[5 * 33], s[6 * 33], s[7 * 33]);
        o.z = pg8::pk4_fp8(s[8 * 33], s[9 * 33], s[10 * 33], s[11 * 33]); o.w = pg8::pk4_fp8(s[12 * 33], s[13 * 33], s[14 * 33], s[15 * 33]);
        const int np = n0 + n; const int orow = gu ? (((np >> 7) << 8) + (np & 127) + upoff) : np;
        *(u32x4*)(WT + (size_t)orow * K + k0 + 16 * c) = o; }
    LDS_WAIT(); asm volatile("" ::: "memory");
}
struct MoeItem { const float* W; unsigned char* WT; int K, N, r, kb2, upoff; bool gu; };

template <bool F8 = false, bool XB = false>
__device__ __forceinline__ void rms_row(const float* __restrict__ xrow, const float* __restrict__ g, bf16* __restrict__ orow, int lane, f32x4 (&v)[8]) {
    const f32x4* xr = (const f32x4*)xrow + lane; const u32x2* xb = (const u32x2*)xrow + lane; float s = 0.f;
#pragma unroll
    for (int j = 0; j < 8; ++j) { if (XB) { const u32x2 w = __builtin_nontemporal_load(xb + 64 * j); v[j] = (f32x4){bflo(w.x), bfhi(w.x), bflo(w.y), bfhi(w.y)}; } else v[j] = __builtin_nontemporal_load(xr + 64 * j);
        s += (v[j].x * v[j].x + v[j].y * v[j].y) + (v[j].z * v[j].z + v[j].w * v[j].w); }
    const float rstd = 1.0f / sqrtf(wave_sum(s, lane) * (1.f / DM) + EPS);
    const f32x4* gr = (const f32x4*)g + lane;
    unsigned long long* o8 = (unsigned long long*)orow + lane;
#pragma unroll
    for (int j = 0; j < 8; ++j) { const f32x4 gg = gr[64 * j]; v[j] = v[j] * rstd * gg;
        if (F8) ((unsigned*)orow)[64 * j + lane] = pg8::pk4_fp8(v[j].x, v[j].y, v[j].z, v[j].w);
        else o8[64 * j] = (unsigned long long)pk2(v[j].x, v[j].y) | ((unsigned long long)pk2(v[j].z, v[j].w) << 32); }
}

template <bool F8 = false, bool XB = false>
__device__ __forceinline__ void norm_phase(Frame& F, const void* X, const float* g, bf16* H) {
    const int gw = F.c * NWAVES + F.wave, NGW = F.G * NWAVES;
    for (int m = gw; m < S; m += NGW) { f32x4 v[8]; const float* xrow = XB ? (const float*)((const bf16*)X + (size_t)m * DM) : (const float*)X + (size_t)m * DM;
        rms_row<F8, XB>(xrow, g, F8 ? (bf16*)((unsigned char*)H + (size_t)m * DM) : H + (size_t)m * DM, F.lane, v); }
}

template <bool XB>
__device__ __forceinline__ void rms_row6(const void* __restrict__ xrow, const float* __restrict__ g, unsigned char* __restrict__ orow, int lane, float (&y)[32]) {
    if (XB) { const u32x4* xb = (const u32x4*)xrow + 4 * lane;
#pragma unroll
        for (int q = 0; q < 4; ++q) { const u32x4 w = __builtin_nontemporal_load(xb + q); y[8 * q] = bflo(w.x); y[8 * q + 1] = bfhi(w.x); y[8 * q + 2] = bflo(w.y); y[8 * q + 3] = bfhi(w.y);
            y[8 * q + 4] = bflo(w.z); y[8 * q + 5] = bfhi(w.z); y[8 * q + 6] = bflo(w.w); y[8 * q + 7] = bfhi(w.w); } }
    else { const f32x4* xf = (const f32x4*)xrow + 8 * lane;
#pragma unroll
        for (int q = 0; q < 8; ++q) { const f32x4 w = __builtin_nontemporal_load(xf + q); y[4 * q] = w.x; y[4 * q + 1] = w.y; y[4 * q + 2] = w.z; y[4 * q + 3] = w.w; } }
    float s = 0.f;
#pragma unroll
    for (int i = 0; i < 32; ++i) s += y[i] * y[i];
    const float rstd = 1.0f / sqrtf(wave_sum(s, lane) * (1.f / DM) + EPS);
    const f32x4* gr = (const f32x4*)g + 8 * lane;
#pragma unroll
    for (int q = 0; q < 8; ++q) { const f32x4 gg = gr[q]; y[4 * q] *= rstd * gg.x; y[4 * q + 1] *= rstd * gg.y; y[4 * q + 2] *= rstd * gg.z; y[4 * q + 3] *= rstd * gg.w; }
    u32x4 p0, p1; mx6_block(y, p0, p1);
    unsigned char* dst = orow + mx6_off(lane);
    *(u32x4*)dst = p0; *(u32x4*)(dst + 64) = p1;
}
template <bool XB>
__device__ __forceinline__ void norm6_phase(Frame& F, const void* X, const float* g, unsigned char* H6) {
    const int gw = F.c * NWAVES + F.wave, NGW = F.G * NWAVES;
    for (int m = gw; m < S; m += NGW) { float y[32]; rms_row6<XB>(XB ? (const void*)((const bf16*)X + (size_t)m * DM) : (const void*)((const float*)X + (size_t)m * DM), g, H6 + (size_t)m * DM, F.lane, y); }
}

__device__ __forceinline__ void p0_prologue(Frame& F) {
    float* scr = (float*)(F.lds + F.wave * 16384);
    const int gw = F.c * NWAVES + F.wave, NGW = F.G * NWAVES;
    unsigned char* ws = F.ws;
    constexpr int I_IN = (DM / 64) * (QKVW / 32), I_OUT = (DM / 64) * (DM / 32), I_GU = (DM / 64) * (DFF / 32), I_DN = (DFF / 64) * (DM / 32);
    constexpr int I_MGU = (DM / 64) * (DEXP / 32), I_MDN = (DEXP / 64) * (DM / 32);
    constexpr int NSMALL = 2 * I_IN + 2 * I_OUT + 2 * I_GU + I_DN;
    for (int it = gw; it < NSMALL; it += NGW) {
        int r = it;
        if (r < 2 * I_IN) { const int l = r / I_IN; r -= l * I_IN; tr_item<false, true>(F.in[2 + 17 * l], DM, QKVW, (bf16*)(ws + WS_WIN) + (size_t)l * QKVW * DM, 0, scr, r, F.lane); continue; } r -= 2 * I_IN;
        if (r < 2 * I_OUT) { const int l = r / I_OUT; r -= l * I_OUT; tr_item<false>(F.in[13 + 17 * l], DM, DM, (bf16*)(ws + WS_WOUT) + (size_t)l * DM * DM, 0, scr, r, F.lane); continue; } r -= 2 * I_OUT;
#if DENSE_GU_FP8
#if GU_FP6
        if (r < 2 * I_GU) { const int up = r / I_GU; r -= up * I_GU; float vv[32]; const int nblk_ = DFF / 32; tr8_load(vv, F.in[15 + up], DFF, r / nblk_, r % nblk_, F.lane);
            tr6_finish(vv, DM, (unsigned char*)(ws + WS_WGU), true, up * 128, scr, r / nblk_, r % nblk_, F.lane); continue; } r -= 2 * I_GU;
#else
        if (r < 2 * I_GU) { const int up = r / I_GU; r -= up * I_GU; tr_item8<true>(F.in[15 + up], DM, DFF, (unsigned char*)(ws + WS_WGU), up * 128, W8SCALE, scr, r, F.lane); continue; } r -= 2 * I_GU;
#endif
#else
        if (r < 2 * I_GU) { const int up = r / I_GU; r -= up * I_GU; tr_item<true>(F.in[15 + up], DM, DFF, (bf16*)(ws + WS_WGU), up * 128, scr, r, F.lane); continue; } r -= 2 * I_GU;
#endif
#if DENSE_DN_FP8
        tr_item8<false>(F.in[17], DFF, DM, (unsigned char*)(ws + WS_WDN), 0, W8SCALE, scr, r, F.lane);
#else
        tr_item<false>(F.in[17], DFF, DM, (bf16*)(ws + WS_WDN), 0, scr, r, F.lane);
#endif
    }
    {
        static_assert(I_MGU == I_MDN, "item counts");
        constexpr int NPM = I_MGU / 2, NPAIR = 3 * NE * NPM;
        const float* const* in = F.in;
#define MOE_PAIR(pp) ({ MoeItem m_; const int which_ = (pp) / (NE * NPM); int r_ = (pp) - which_ * (NE * NPM); const int e_ = r_ / NPM; r_ -= e_ * NPM; \
            if (which_ < 2) { m_.W = in[33 + which_] + (size_t)e_ * DM * DEXP; m_.WT = (unsigned char*)(ws + WS_MGU) + (size_t)e_ * 2 * DEXP * DM; m_.K = DM; m_.N = DEXP; m_.upoff = which_ * 128; m_.gu = true; } \
            else { m_.W = in[35] + (size_t)e_ * DEXP * DM; m_.WT = (unsigned char*)(ws + WS_MDN) + (size_t)e_ * DM * DEXP; m_.K = DEXP; m_.N = DM; m_.upoff = 0; m_.gu = false; } \
            const int nblk_ = m_.N / 32; m_.r = r_ % nblk_  ; m_.kb2 = r_ / nblk_; m_; })
        float va[32], vb[32];
        if (gw < NPAIR) { const MoeItem m = MOE_PAIR(gw); tr8_load(va, m.W, m.N, 2 * m.kb2, m.r, F.lane); }
        for (int pp = gw; pp < NPAIR; pp += NGW) {
            const MoeItem m = MOE_PAIR(pp);
            tr8_load(vb, m.W, m.N, 2 * m.kb2 + 1, m.r, F.lane);
            if (GU_FP6 && m.gu) tr6_finish(va, m.K, m.WT, true, m.upoff, scr, 2 * m.kb2, m.r, F.lane);
            else tr8_finish(va, m.K, m.N, m.WT, m.gu, m.upoff, W8SCALE, scr, 2 * m.kb2, m.r, F.lane);
            if (pp + NGW < NPAIR) { const MoeItem m2 = MOE_PAIR(pp + NGW); tr8_load(va, m2.W, m2.N, 2 * m2.kb2, m2.r, F.lane); }
            if (GU_FP6 && m.gu) tr6_finish(vb, m.K, m.WT, true, m.upoff, scr, 2 * m.kb2 + 1, m.r, F.lane);
            else tr8_finish(vb, m.K, m.N, m.WT, m.gu, m.upoff, W8SCALE, scr, 2 * m.kb2 + 1, m.r, F.lane);
        }
#undef MOE_PAIR
    }
    {
        float* cosA = (float*)(ws + WS_ROPE); float* sinA = cosA + (size_t)S * 32; float* cosB = sinA + (size_t)S * 32; float* sinB = cosB + (size_t)S * 64;
        const int gt = F.c * NTHR + F.tid, NGT = F.G * NTHR;
        for (int idx = gt; idx < S * 96; idx += NGT) {
            const int pos = idx / 96, j = idx % 96; const bool isA = j < 32; const int i = isA ? j : j - 32;
            const double r = isA ? 0.7498942093324559 : 0.8659643233600653;
            double inv = 1.0; for (int q = 0; q < i; ++q) inv *= r;
            double t = (double)pos * inv * 0.15915494309189535; t -= __builtin_rint(t);
            const float tf = (float)t; const float sn = __builtin_amdgcn_sinf(tf), cs = __builtin_amdgcn_cosf(tf);
            if (isA) { cosA[(size_t)pos * 32 + i] = cs; sinA[(size_t)pos * 32 + i] = sn; } else { cosB[(size_t)pos * 64 + i] = cs; sinB[(size_t)pos * 64 + i] = sn; }
        }
    }
    norm_phase<false, false>(F, F.in[0], F.in[1], (bf16*)(ws + WS_H));
}

template <int GRP>
__device__ __forceinline__ void qknorm_rope_seg(bf16* seg, const float* __restrict__ gain, const float* __restrict__ ct, const float* __restrict__ st, float qscale, int lane) {
    constexpr int DIMS = GRP * 16, HALFD = DIMS / 2;
    u32x4 w0 = *(const u32x4*)(seg + 16 * lane), w1 = *(const u32x4*)(seg + 16 * lane + 8);
    float x[16];
    x[0] = bflo(w0.x); x[1] = bfhi(w0.x); x[2] = bflo(w0.y); x[3] = bfhi(w0.y); x[4] = bflo(w0.z); x[5] = bfhi(w0.z); x[6] = bflo(w0.w); x[7] = bfhi(w0.w);
    x[8] = bflo(w1.x); x[9] = bfhi(w1.x); x[10] = bflo(w1.y); x[11] = bfhi(w1.y); x[12] = bflo(w1.z); x[13] = bfhi(w1.z); x[14] = bflo(w1.w); x[15] = bfhi(w1.w);
    float ss = 0.f;
#pragma unroll
    for (int e = 0; e < 16; ++e) ss += x[e] * x[e];
#pragma unroll
    for (int o = 1; o < GRP; o <<= 1) ss += shflx(ss, o, lane);
    const float rstd = 1.0f / sqrtf(ss * (1.f / DIMS) + EPS);
    const int j0 = 16 * (lane & (GRP - 1));
    const int jj0 = j0 & (HALFD - 1);
    const bool first = j0 < HALFD;
    float y[16], o[16];
#pragma unroll
    for (int e = 0; e < 16; ++e) y[e] = x[e] * rstd * gain[j0 + e];
#pragma unroll
    for (int e = 0; e < 16; ++e) { const float p = shflx(y[e], GRP / 2, lane); const float cs = ct[jj0 + e], sn = st[jj0 + e];
        o[e] = (y[e] * cs + (first ? -p : p) * sn) * qscale; }
    u32x4 r0, r1;
    r0.x = pk2(o[0], o[1]); r0.y = pk2(o[2], o[3]); r0.z = pk2(o[4], o[5]); r0.w = pk2(o[6], o[7]);
    r1.x = pk2(o[8], o[9]); r1.y = pk2(o[10], o[11]); r1.z = pk2(o[12], o[13]); r1.w = pk2(o[14], o[15]);
    *(u32x4*)(seg + 16 * lane) = r0; *(u32x4*)(seg + 16 * lane + 8) = r1;
}
__device__ __forceinline__ void qknorm_rope_phase(Frame& F, int l, size_t qkv_off = WS_QKV) {
    const int gw = F.c * NWAVES + F.wave, NGW = F.G * NWAVES;
    bf16* QKV = (bf16*)(F.ws + qkv_off);
    const float* cosA = (const float*)(F.ws + WS_ROPE); const float* sinA = cosA + (size_t)S * 32; const float* cosB = sinA + (size_t)S * 32; const float* sinB = cosB + (size_t)S * 64;
    const float* dqn = F.in[1 + 17 * l + 2]; const float* dkn = F.in[1 + 17 * l + 3]; const float* bqn = F.in[1 + 17 * l + 9]; const float* bkn = F.in[1 + 17 * l + 10];
    for (int m = gw; m < S; m += NGW) {
        bf16* row = QKV + (size_t)m * QKVW;
        qknorm_rope_seg<4>(row, dqn, cosA + (size_t)m * 32, sinA + (size_t)m * 32, 0.125f * LOG2E, F.lane);
        qknorm_rope_seg<4>(row + 1024, dkn, cosA + (size_t)m * 32, sinA + (size_t)m * 32, 1.0f, F.lane);
        qknorm_rope_seg<8>(row + 3072, bqn, cosB + (size_t)m * 64, sinB + (size_t)m * 64, 0.08838834764831845f * LOG2E, F.lane);
        qknorm_rope_seg<8>(row + 4096, bkn, cosB + (size_t)m * 64, sinB + (size_t)m * 64, 1.0f, F.lane);
    }
}

__device__ __forceinline__ void dil_combine_phase(Frame& F, int l) {
    const int gw = F.c * NWAVES + F.wave, NGW = F.G * NWAVES, lane = F.lane;
    const bf16* OP = (const bf16*)(F.ws + WS_DILP); const float* LP = (const float*)(F.ws + WS_DILL);
    bf16* AO = (bf16*)(F.ws + WS_AO); const float* bon = F.in[1 + 17 * l + 11];
    const int head = lane >> 3, cb = (16 * lane) & 127;
    for (int m = gw; m < S; m += NGW) {
        f32x4 a[4]; float ls = 0.f;
#pragma unroll
        for (int q = 0; q < 4; ++q) a[q] = (f32x4){0.f, 0.f, 0.f, 0.f};
#pragma unroll
        for (int b = 0; b < 3; ++b) { const u32x4* p = (const u32x4*)(OP + ((size_t)b * S + m) * 1024 + 16 * lane); const u32x4 w0 = __builtin_nontemporal_load(p), w1 = __builtin_nontemporal_load(p + 1);
            a[0] += (f32x4){bflo(w0.x), bfhi(w0.x), bflo(w0.y), bfhi(w0.y)}; a[1] += (f32x4){bflo(w0.z), bfhi(w0.z), bflo(w0.w), bfhi(w0.w)};
            a[2] += (f32x4){bflo(w1.x), bfhi(w1.x), bflo(w1.y), bfhi(w1.y)}; a[3] += (f32x4){bflo(w1.z), bfhi(w1.z), bflo(w1.w), bfhi(w1.w)};
            ls += LP[((size_t)b * S + m) * 8 + head]; }
        const float il = 1.0f / ls; float ss = 0.f;
#pragma unroll
        for (int q = 0; q < 4; ++q) { a[q] = a[q] * il; ss += (a[q].x * a[q].x + a[q].y * a[q].y) + (a[q].z * a[q].z + a[q].w * a[q].w); }
        ss += shflx(ss, 1, lane); ss += shflx(ss, 2, lane); ss += shflx(ss, 4, lane);
        const float rstd = 1.0f / sqrtf(ss * (1.f / 128.f) + EPS);
        u32x4 r0, r1; const f32x4* gp = (const f32x4*)(bon + cb);
        f32x4 g0 = gp[0], g1 = gp[1], g2 = gp[2], g3 = gp[3];
        a[0] = a[0] * rstd * g0; a[1] = a[1] * rstd * g1; a[2] = a[2] * rstd * g2; a[3] = a[3] * rstd * g3;
        r0.x = pk2(a[0].x, a[0].y); r0.y = pk2(a[0].z, a[0].w); r0.z = pk2(a[1].x, a[1].y); r0.w = pk2(a[1].z, a[1].w);
        r1.x = pk2(a[2].x, a[2].y); r1.y = pk2(a[2].z, a[2].w); r1.z = pk2(a[3].x, a[3].y); r1.w = pk2(a[3].z, a[3].w);
        bf16* o = AO + (size_t)m * DM + 1024 + 16 * lane;
        *(u32x4*)o = r0; *(u32x4*)(o + 8) = r1;
    }
}

__device__ __forceinline__ void norm_router_phase(Frame& F, const bf16* X, const float* g, bf16* H, const float* router) {
    float* Rt = (float*)F.lds;
    int* cnt = (int*)(F.lds + 65536);
    for (int idx = F.tid; idx < DM * NE; idx += NTHR) { const int j = idx >> 3, e = idx & 7; Rt[e * DM + j] = router[idx]; }
    if (F.tid < 8) cnt[F.tid] = 0;
    __syncthreads();
    int* TKE = (int*)(F.ws + WS_TOK + TK_E); float* TKG = (float*)(F.ws + WS_TOK + TK_G);
    const int lane = F.lane;
    for (int i = 0; i < 8; ++i) {
        const int m = 64 * F.c + 8 * F.wave + i;
        f32x4 v[8]; rms_row<true, true>((const float*)(X + (size_t)m * DM), g, (bf16*)((unsigned char*)H + (size_t)m * DM), lane, v);
        float lg[8];
#pragma unroll
        for (int e = 0; e < 8; ++e) { float a = 0.f;
#pragma unroll
            for (int j = 0; j < 8; ++j) { const f32x4 r = *(const f32x4*)(Rt + e * DM + 256 * j + 4 * lane); a += (v[j].x * r.x + v[j].y * r.y) + (v[j].z * r.z + v[j].w * r.w); }
            lg[e] = wave_sum(a, lane); }
        int e0 = 0; float v0 = lg[0];
#pragma unroll
        for (int e = 1; e < 8; ++e) if (lg[e] > v0) { v0 = lg[e]; e0 = e; }
        int e1 = -1; float v1 = -3.0e38f;
#pragma unroll
        for (int e = 0; e < 8; ++e) if (e != e0 && lg[e] > v1) { v1 = lg[e]; e1 = e; }
        const float g0 = 1.0f / (1.0f + __expf(v1 - v0)), g1 = 1.0f - g0;
        if (lane == 0) { TKE[2 * m] = e0; TKE[2 * m + 1] = e1; TKG[2 * m] = g0; TKG[2 * m + 1] = g1; atomicAdd(&cnt[e0], 1); atomicAdd(&cnt[e1], 1); }
    }
    __syncthreads();
    if (F.tid < 8) ((int*)(F.ws + WS_TOK + TK_WGCNT))[F.c * 8 + F.tid] = cnt[F.tid];
    __syncthreads();
}

__device__ __forceinline__ void norm_router6_phase(Frame& F, const bf16* X, const float* g, unsigned char* H6, const float* router) {
    float* Rt = (float*)F.lds;
    int* cnt = (int*)(F.lds + 65536);
    for (int idx = F.tid; idx < DM * NE; idx += NTHR) { const int j = idx >> 3, e = idx & 7, l = j >> 5, i = j & 31; Rt[e * DM + ((i >> 2) * 64 + l) * 4 + (i & 3)] = router[idx]; }
    if (F.tid < 8) cnt[F.tid] = 0;
    __syncthreads();
    int* TKE = (int*)(F.ws + WS_TOK + TK_E); float* TKG = (float*)(F.ws + WS_TOK + TK_G);
    const int lane = F.lane;
    for (int i = 0; i < 8; ++i) {
        const int m = 64 * F.c + 8 * F.wave + i;
        float y[32]; rms_row6<true>((const void*)(X + (size_t)m * DM), g, H6 + (size_t)m * DM, lane, y);
        float lg[8];
#pragma unroll
        for (int e = 0; e < 8; ++e) { float a = 0.f;
#pragma unroll
            for (int q = 0; q < 8; ++q) { const f32x4 r = *(const f32x4*)(Rt + e * DM + (q * 64 + lane) * 4); a += (y[4 * q] * r.x + y[4 * q + 1] * r.y) + (y[4 * q + 2] * r.z + y[4 * q + 3] * r.w); }
            lg[e] = wave_sum(a, lane); }
        int e0 = 0; float v0 = lg[0];
#pragma unroll
        for (int e = 1; e < 8; ++e) if (lg[e] > v0) { v0 = lg[e]; e0 = e; }
        int e1 = -1; float v1 = -3.0e38f;
#pragma unroll
        for (int e = 0; e < 8; ++e) if (e != e0 && lg[e] > v1) { v1 = lg[e]; e1 = e; }
        const float g0 = 1.0f / (1.0f + __expf(v1 - v0)), g1 = 1.0f - g0;
        if (lane == 0) { TKE[2 * m] = e0; TKE[2 * m + 1] = e1; TKG[2 * m] = g0; TKG[2 * m + 1] = g1; atomicAdd(&cnt[e0], 1); atomicAdd(&cnt[e1], 1); }
    }
    __syncthreads();
    if (F.tid < 8) ((int*)(F.ws + WS_TOK + TK_WGCNT))[F.c * 8 + F.tid] = cnt[F.tid];
    __syncthreads();
}

__device__ __forceinline__ void moe_scatter_phase(Frame& F) {
    int* call = (int*)F.lds;
    int* tot = call + 2048; int* before = tot + 8; int* base = before + 8; int* pstart = base + 8; int* rowmap = pstart + 16;
    const int* WGC = (const int*)(F.ws + WS_TOK + TK_WGCNT);
    for (int idx = F.tid; idx < 2048; idx += NTHR) call[idx] = WGC[idx];
    __syncthreads();
    {
        const int e = F.wave, lane = F.lane; int t = 0, b = 0;
#pragma unroll
        for (int k = 0; k < 4; ++k) { const int w = lane + 64 * k; const int x = call[w * 8 + e]; t += x; b += (w < F.c) ? x : 0; }
#pragma unroll
        for (int o = 1; o < 64; o <<= 1) { t += __builtin_amdgcn_ds_bpermute((lane ^ o) << 2, t); b += __builtin_amdgcn_ds_bpermute((lane ^ o) << 2, b); }
        if (lane == 0) { tot[e] = t; before[e] = b; } }
    __syncthreads();
    if (F.tid == 0) { int ps = 0; for (int e = 0; e < 8; ++e) { pstart[e] = ps; base[e] = ps + before[e]; ps += ((tot[e] + 255) >> 8) << 8; } pstart[8] = ps;
        if (F.c == 0) { int* meta = (int*)(F.ws + WS_TOK + TK_META); for (int e = 0; e <= 8; ++e) meta[e] = pstart[e] >> 8; } }
    __syncthreads();
    const int* TKE = (const int*)(F.ws + WS_TOK + TK_E); int* TKP = (int*)(F.ws + WS_TOK + TK_POS);
    {
        const int e = F.wave, lane = F.lane, s0 = 64 * F.c * 2 + lane, s1 = s0 + 64;
        const bool f0 = TKE[s0] == e, f1 = TKE[s1] == e;
        const unsigned long long m0 = __builtin_amdgcn_ballot_w64(f0), m1 = __builtin_amdgcn_ballot_w64(f1), lt = (1ull << lane) - 1ull;
        const int r0 = base[e] + __builtin_popcountll(m0 & lt), r1 = base[e] + __builtin_popcountll(m0) + __builtin_popcountll(m1 & lt);
        if (f0) { rowmap[lane] = r0; TKP[s0] = r0; }
        if (f1) { rowmap[lane + 64] = r1; TKP[s1] = r1; } }
    __syncthreads();
    const bf16* H = (const bf16*)(F.ws + WS_H); bf16* XG = (bf16*)(F.ws + WS_XG);
    for (int a = F.wave * 16; a < F.wave * 16 + 16; ++a) {
        const int tok = 64 * F.c + (a >> 1), pos = rowmap[a];
        const u32x4* src = (const u32x4*)((const unsigned char*)H + (size_t)tok * DM) + F.lane; u32x4* dst = (u32x4*)((unsigned char*)XG + (size_t)pos * DM) + F.lane;
#pragma unroll
        for (int q = 0; q < 2; ++q) dst[64 * q] = src[64 * q];
    }
    for (int e = 0; e < 8; ++e) { const int r0 = pstart[e] + tot[e], r1 = pstart[e + 1];
        for (int r = r0 + F.wave; r < r1; r += NWAVES) if (((r & 255) % F.G) == F.c % 256) { u32x4* dst = (u32x4*)((unsigned char*)XG + (size_t)r * DM) + F.lane;
#pragma unroll
            for (int q = 0; q < 2; ++q) dst[64 * q] = (u32x4){0u, 0u, 0u, 0u}; } }
    __syncthreads();
}

__device__ __forceinline__ void moe_combine_phase(Frame& F) {
    const int gw = F.c * NWAVES + F.wave, NGW = F.G * NWAVES, lane = F.lane;
    const float* TKG = (const float*)(F.ws + WS_TOK + TK_G); const int* TKP = (const int*)(F.ws + WS_TOK + TK_POS);
    const bf16* YE = (const bf16*)(F.ws + WS_YE);
    for (int m = gw; m < S; m += NGW) {
        const float g0 = TKG[2 * m] * W8INV, g1 = TKG[2 * m + 1] * W8INV; const int p0 = TKP[2 * m], p1 = TKP[2 * m + 1];
        f32x4* xr = (f32x4*)(F.out + (size_t)m * DM) + lane; const u32x2* xb = (const u32x2*)((const bf16*)(F.ws + WS_XRB) + (size_t)m * DM) + lane;
        const u32x2* y0 = (const u32x2*)(YE + (size_t)p0 * DM) + lane; const u32x2* y1 = (const u32x2*)(YE + (size_t)p1 * DM) + lane;
#pragma unroll
        for (int j = 0; j < 8; ++j) { const u32x2 xw = __builtin_nontemporal_load(xb + 64 * j); f32x4 x = {bflo(xw.x), bfhi(xw.x), bflo(xw.y), bfhi(xw.y)}; const u32x2 a = __builtin_nontemporal_load(y0 + 64 * j), b = __builtin_nontemporal_load(y1 + 64 * j);
            x.x += g0 * bflo(a.x) + g1 * bflo(b.x); x.y += g0 * bfhi(a.x) + g1 * bfhi(b.x); x.z += g0 * bflo(a.y) + g1 * bflo(b.y); x.w += g0 * bfhi(a.y) + g1 * bfhi(b.y);
            xr[64 * j] = x; }
    }
}
#ifndef ATT_SDEPTH
#define ATT_SDEPTH 1
#endif
constexpr int SDEPTH = ATT_SDEPTH;
#ifndef DIFF_PV8
#define DIFF_PV8 1
#endif
constexpr size_t SHM_V = 64 * 128 * 2, SHM_K = 64 * 128 * 2;
#define KSWZ(row, colB) ((row) * 256 + ((colB) ^ (((row) & 7) << 4)))
__device__ __forceinline__ int crow(int r, int hi) { return (r & 3) + 8 * (r >> 2) + 4 * hi; }
__device__ __forceinline__ int v_st(int k, int c) { const int kk = (k & ~0xC) | ((k & 4) << 1) | ((k & 8) >> 1); return ((kk >> 3) * 4 + (c >> 5)) * 512 + ((kk & 7) * 32 + (c & 31)) * 2; }
__device__ __forceinline__ int v_rd_base(int lane) { return ((lane & 3) << 3) | (((lane >> 2) & 3) << 6) | (((lane >> 4) & 1) << 5) | (((lane >> 5) & 1) << 8); }
constexpr int v_rd_off(int d0, int ks, int half) { return d0 * 512 + ks * 4096 + half * 2048; }
template <int OFF> __device__ __forceinline__ s16x4 tr_read(int vb) {
    s16x4 r; asm volatile("ds_read_b64_tr_b16 %0, %1 offset:%2" : "=&v"(r) : "v"(vb), "i"(OFF) : "memory"); return r;
}
template <int D0> __device__ __forceinline__ void pv_one(f32x16& od, int vb, bf16x8 pa0, bf16x8 pa1, bf16x8 pa2, bf16x8 pa3) {
    const s16x4 l0 = tr_read<v_rd_off(D0, 0, 0)>(vb), h0 = tr_read<v_rd_off(D0, 0, 1)>(vb), l1 = tr_read<v_rd_off(D0, 1, 0)>(vb), h1 = tr_read<v_rd_off(D0, 1, 1)>(vb);
    const s16x4 l2 = tr_read<v_rd_off(D0, 2, 0)>(vb), h2 = tr_read<v_rd_off(D0, 2, 1)>(vb), l3 = tr_read<v_rd_off(D0, 3, 0)>(vb), h3 = tr_read<v_rd_off(D0, 3, 1)>(vb);
    asm volatile("s_waitcnt lgkmcnt(0)" ::: "memory"); SBAR();
#define PK(L, H) (bf16x8){L[0], L[1], L[2], L[3], H[0], H[1], H[2], H[3]}
    od = __builtin_amdgcn_mfma_f32_32x32x16_bf16(pa0, PK(l0, h0), od, 0, 0, 0);
    od = __builtin_amdgcn_mfma_f32_32x32x16_bf16(pa1, PK(l1, h1), od, 0, 0, 0);
    od = __builtin_amdgcn_mfma_f32_32x32x16_bf16(pa2, PK(l2, h2), od, 0, 0, 0);
    od = __builtin_amdgcn_mfma_f32_32x32x16_bf16(pa3, PK(l3, h3), od, 0, 0, 0);
#undef PK
}
__device__ __forceinline__ void pv_d0(f32x16 (&o)[4], int vb, bf16x8 pa0, bf16x8 pa1, bf16x8 pa2, bf16x8 pa3) {
    pv_one<0>(o[0], vb, pa0, pa1, pa2, pa3); pv_one<1>(o[1], vb, pa0, pa1, pa2, pa3); pv_one<2>(o[2], vb, pa0, pa1, pa2, pa3); pv_one<3>(o[3], vb, pa0, pa1, pa2, pa3);
}
template <int NQ>
__device__ __forceinline__ void qkt(f32x16& p0, f32x16& p1, const char* Ks, const bf16x8 (&qr)[NQ], int r32, int hi, int kd0, float negb) {
    if (negb == 0.f) { p0 = f32x16{}; p1 = f32x16{}; }
    else {
#pragma unroll
        for (int r = 0; r < 16; ++r) { p0[r] = negb; p1[r] = negb; } }
#pragma unroll
    for (int d0 = 0; d0 < NQ; ++d0) { const int cb = (kd0 + d0 * 16 + hi * 8) * 2;
        const bf16x8 b0 = *reinterpret_cast<const bf16x8*>(Ks + KSWZ(r32, cb));
        const bf16x8 b1 = *reinterpret_cast<const bf16x8*>(Ks + KSWZ(32 + r32, cb));
        p0 = __builtin_amdgcn_mfma_f32_32x32x16_bf16(b0, qr[d0], p0, 0, 0, 0);
        p1 = __builtin_amdgcn_mfma_f32_32x32x16_bf16(b1, qr[d0], p1, 0, 0, 0); }
}
template <bool DIL>
__device__ __forceinline__ void sm_half(f32x16& p, int dbase, int mq, int L) {
#pragma unroll
    for (int r = 0; r < 16; ++r) { const float e = __builtin_amdgcn_exp2f(p[r]);
        if (DIL) { const int lo = (-mq > -64) ? -mq : -64, hi_ = (L - 1 - mq < 64) ? (L - 1 - mq) : 64;
            const bool ok = (unsigned)(dbase - lo + (r & 3) + 8 * (r >> 2)) <= (unsigned)(hi_ - lo); p[r] = ok ? e : 0.f; }
        else p[r] = e; }
}
__device__ __forceinline__ void sm_half_nomask(f32x16& p) {
#pragma unroll
    for (int r = 0; r < 16; ++r) p[r] = __builtin_amdgcn_exp2f(p[r]);
}
__device__ __forceinline__ void finish_sm(const f32x16& p0, const f32x16& p1, float& l_reg, bf16x8& pa0, bf16x8& pa1, bf16x8& pa2, bf16x8& pa3) {
    float ps = 0;
#pragma unroll
    for (int r = 0; r < 16; ++r) ps += p0[r];
#pragma unroll
    for (int r = 0; r < 16; ++r) ps += p1[r];
    { auto rr = __builtin_amdgcn_permlane32_swap(__float_as_uint(ps), __float_as_uint(ps), false, false);
      ps = __uint_as_float(rr[0]) + __uint_as_float(rr[1]); }
    l_reg += ps;
#define PK4(P, BASE, OUT) do { unsigned a0 = cvtpk(P[BASE + 0], P[BASE + 1]), a1 = cvtpk(P[BASE + 2], P[BASE + 3]);   \
    unsigned b0 = cvtpk(P[BASE + 4], P[BASE + 5]), b1 = cvtpk(P[BASE + 6], P[BASE + 7]);                              \
    auto r0 = __builtin_amdgcn_permlane32_swap(a0, b0, false, false); auto r1 = __builtin_amdgcn_permlane32_swap(a1, b1, false, false); \
    u32x4 w = {r0[0], r1[0], r0[1], r1[1]}; OUT = *reinterpret_cast<bf16x8*>(&w); } while (0)
    PK4(p0, 0, pa0); PK4(p0, 8, pa1); PK4(p1, 0, pa2); PK4(p1, 8, pa3);
#undef PK4
}

constexpr int SLOTB = 32768;
template <int NQ, bool DIL>
__device__ __forceinline__ void attn_core(const bf16* __restrict__ QKV, int dil, int res, int L, int mq0, int mk0, int NT, int kcol, int vcol, int kd0, float negb,
                                          const bf16x8 (&qr)[NQ], char* lds, f32x16 (&o)[4], float& l_reg, int tid) {
    asm volatile("" : "+v"(tid));
    const int lane = tid & 63, r32 = lane & 31, hi = lane >> 5, wv = __builtin_amdgcn_readfirstlane(tid >> 6);
    const int vbl = (int)(uintptr_t)lds + v_rd_base(lane);
    const int mq = mq0 + r32;
    const __amdgpu_buffer_rsrc_t rq = __builtin_amdgcn_make_buffer_rsrc((void*)QKV, 0, 0xffffffffu, 0x00020000);
    int rowK[2], colK[2], rowV[2], colV[2];
#pragma unroll
    for (int i = 0; i < 2; ++i) { const int q = 2 * wv + i;
        rowK[i] = 4 * q + (lane >> 4); colK[i] = kcol + 8 * ((lane & 15) ^ (rowK[i] & 7));
        const int sidx = 2 * q + (lane >> 5), piece = lane & 31, kk = (sidx >> 2) * 8 + (piece >> 2);
        rowV[i] = (kk & ~0xC) | ((kk & 4) << 1) | ((kk & 8) >> 1); colV[i] = vcol + (sidx & 3) * 32 + (piece & 3) * 8; }
    LAS unsigned char* ldsl = (LAS unsigned char*)(unsigned)(uintptr_t)lds;
#define VOFF(t, row, col) ({ int mk_ = mk0 + 64 * (t) + (row); if (DIL) mk_ = mk_ < 0 ? 0 : (mk_ > L - 1 ? L - 1 : mk_); (int)(((unsigned)(mk_ * dil + res) * (unsigned)QKVW + (unsigned)(col)) * 2u); })
#define DMA(t) do { const int sb_ = ((t) & 3) * SLOTB; _Pragma("unroll") for (int i_ = 0; i_ < 2; ++i_) { \
        __builtin_amdgcn_raw_ptr_buffer_load_lds(rq, (LAS unsigned*)(ldsl + sb_ + (2 * wv + i_) * 1024), 16, VOFF(t, rowV[i_], colV[i_]), 0, 0, 0); \
        __builtin_amdgcn_raw_ptr_buffer_load_lds(rq, (LAS unsigned*)(ldsl + sb_ + 16384 + (2 * wv + i_) * 1024), 16, VOFF(t, rowK[i_], colK[i_]), 0, 0, 0); } } while (0)
#define BAR() do { asm volatile("" ::: "memory"); __builtin_amdgcn_s_barrier(); asm volatile("" ::: "memory"); } while (0)
#define DB0(t) (mk0 + 64 * (t) + 4 * hi - mq)
#define ACT(t) (!DIL || ((mk0 + 64 * (t) + 63 >= mq0 - 64) && (mk0 + 64 * (t) <= mq0 + 31 + 64)))
#define FULLV(t, off) (DIL && (mk0 + 64 * (t) + (off) >= mq0 + 31 - 64) && (mk0 + 64 * (t) + (off) + 31 <= mq0 + 64) && (mk0 + 64 * (t) + (off) >= 0) && (mk0 + 64 * (t) + (off) + 31 < L))
#define SMH(P, t, off) do { if (FULLV(t, off)) sm_half_nomask(P); else sm_half<DIL>(P, DB0(t) + (off), mq, L); } while (0)
#define KS(t) (lds + ((t) & 3) * SLOTB + 16384)
#define VB(t) (vbl + ((t) & 3) * SLOTB)
    f32x16 pA0, pA1, pB0, pB1; bf16x8 pa0, pa1, pa2, pa3;
    DMA(0); DMA(1);
    asm volatile("s_waitcnt vmcnt(4)" ::: "memory"); BAR();
    if (2 < NT) DMA(2);
    if (ACT(0)) { qkt<NQ>(pA0, pA1, KS(0), qr, r32, hi, kd0, negb); SMH(pA0, 0, 0); }
    for (int j = 1; j + 1 < NT; j += 2) {
        asm volatile("s_waitcnt vmcnt(4)" ::: "memory"); BAR();
        DMA(j + 2);
        SBAR(); if (ACT(j)) qkt<NQ>(pB0, pB1, KS(j), qr, r32, hi, kd0, negb);
        if (ACT(j - 1)) { SMH(pA1, j - 1, 32); finish_sm(pA0, pA1, l_reg, pa0, pa1, pa2, pa3); } SBAR();
        if (ACT(j - 1)) pv_d0(o, VB(j - 1), pa0, pa1, pa2, pa3);
        if (ACT(j)) SMH(pB0, j, 0);
        if (j + 3 < NT) { asm volatile("s_waitcnt vmcnt(4)" ::: "memory"); } else { asm volatile("s_waitcnt vmcnt(0)" ::: "memory"); }
        BAR();
        if (j + 3 < NT) DMA(j + 3);
        SBAR(); if (ACT(j + 1)) qkt<NQ>(pA0, pA1, KS(j + 1), qr, r32, hi, kd0, negb);
        if (ACT(j)) { SMH(pB1, j, 32); finish_sm(pB0, pB1, l_reg, pa0, pa1, pa2, pa3); } SBAR();
        if (ACT(j)) pv_d0(o, VB(j), pa0, pa1, pa2, pa3);
        if (ACT(j + 1)) SMH(pA0, j + 1, 0);
    }
    asm volatile("s_waitcnt vmcnt(0)" ::: "memory"); BAR();
    SBAR(); if (ACT(NT - 1)) qkt<NQ>(pB0, pB1, KS(NT - 1), qr, r32, hi, kd0, negb);
    if (ACT(NT - 2)) { SMH(pA1, NT - 2, 32); finish_sm(pA0, pA1, l_reg, pa0, pa1, pa2, pa3); } SBAR();
    if (ACT(NT - 2)) pv_d0(o, VB(NT - 2), pa0, pa1, pa2, pa3);
    if (ACT(NT - 1)) { SMH(pB0, NT - 1, 0);
        SMH(pB1, NT - 1, 32); finish_sm(pB0, pB1, l_reg, pa0, pa1, pa2, pa3); } SBAR();
    if (ACT(NT - 1)) pv_d0(o, VB(NT - 1), pa0, pa1, pa2, pa3);
    __syncthreads();
#undef VOFF
#undef DMA
#undef BAR
#undef DB0
#undef FULLV
#undef SMH
#undef ACT
#undef KS
#undef VB
}


__device__ __forceinline__ int v8_key(int s) { const int g = s >> 5, q = s & 31; return q < 16 ? crow(q, g) : 32 + crow(q - 16, g); }
__device__ __forceinline__ void v8t_phase(Frame& F) {
    const int gw = F.c * NWAVES + F.wave, NGW = F.G * NWAVES, lane = F.lane;
    const bf16* QKV = (const bf16*)(F.ws + WS_QKV); unsigned char* V8T = (unsigned char*)(F.ws + WS_V8T);
    unsigned char* scr = (unsigned char*)(F.lds + F.wave * 16384);
    for (int u = gw; u < 8 * 256; u += NGW) {
        const int h = u & 7, tile = u >> 3;
        const bf16* row = QKV + (size_t)(64 * tile + lane) * QKVW + 2048 + h * 128;
        u32x4 w[16];
#pragma unroll
        for (int j = 0; j < 16; ++j) w[j] = *(const u32x4*)(row + 8 * j);
#pragma unroll
        for (int j = 0; j < 16; ++j) { unsigned* d = (unsigned*)(scr + lane * 132 + 8 * j);
            d[0] = pg8::pk4_fp8(bflo(w[j].x), bfhi(w[j].x), bflo(w[j].y), bfhi(w[j].y)); d[1] = pg8::pk4_fp8(bflo(w[j].z), bfhi(w[j].z), bflo(w[j].w), bfhi(w[j].w)); }
        LDS_WAIT(); asm volatile("" ::: "memory");
        unsigned lo[16], hi2[16];
#pragma unroll
        for (int j = 0; j < 16; ++j) { unsigned a = 0, b = 0;
#pragma unroll
            for (int q = 0; q < 4; ++q) { const unsigned short t = *(const unsigned short*)(scr + v8_key(4 * j + q) * 132 + 2 * lane); a |= (unsigned)(t & 0xff) << (8 * q); b |= (unsigned)(t >> 8) << (8 * q); }
            lo[j] = a; hi2[j] = b; }
        u32x4* dst = (u32x4*)(V8T + ((size_t)(h * 256 + tile) * 128 + 2 * lane) * 64);
#pragma unroll
        for (int q = 0; q < 4; ++q) { dst[q] = (u32x4){lo[4 * q], lo[4 * q + 1], lo[4 * q + 2], lo[4 * q + 3]}; dst[4 + q] = (u32x4){hi2[4 * q], hi2[4 * q + 1], hi2[4 * q + 2], hi2[4 * q + 3]}; }
        LDS_WAIT(); asm volatile("" ::: "memory");
    }
}
typedef int i32x8a __attribute__((ext_vector_type(8)));
typedef int i32x4a __attribute__((ext_vector_type(4)));
constexpr int SLOT8 = 24576;
#ifndef L_MFMA
#define L_MFMA 1
#endif
__device__ __forceinline__ int pk4_fp8_inplace(float a, float b, float c, float d) { int w = __builtin_bit_cast(int, a); w = __builtin_amdgcn_cvt_pk_fp8_f32(a, b, w, false); w = __builtin_amdgcn_cvt_pk_fp8_f32(c, d, w, true); return w; }
__device__ __forceinline__ void finish_sm8(const f32x16& p0, const f32x16& p1, float& l_reg, i32x8a& A8) {
#if !L_MFMA
    float ps = 0;
#pragma unroll
    for (int r = 0; r < 16; ++r) ps += p0[r];
#pragma unroll
    for (int r = 0; r < 16; ++r) ps += p1[r];
    l_reg += ps;
#endif
#pragma unroll
    for (int j = 0; j < 4; ++j) { A8[j] = pk4_fp8_inplace(p0[4 * j], p0[4 * j + 1], p0[4 * j + 2], p0[4 * j + 3]); A8[4 + j] = pk4_fp8_inplace(p1[4 * j], p1[4 * j + 1], p1[4 * j + 2], p1[4 * j + 3]); }
}
#if L_MFMA
#define PV8_NOP ""
#else
#define PV8_NOP "s_nop 1\n\t"
#endif
__device__ __forceinline__ void pv8(f32x16 (&o)[4], f32x16& ol, const i32x4a& ones, const LAS unsigned char* vb0, const LAS unsigned char* vb1, const i32x8a& A8) {
    i32x8a vf[4];
#pragma unroll
    for (int d = 0; d < 4; ++d) { const i32x4a x = *(const LAS i32x4a*)(vb0 + d * 2048), y = *(const LAS i32x4a*)(vb1 + d * 2048); vf[d] = __builtin_shufflevector(x, y, 0, 1, 2, 3, 4, 5, 6, 7); }
#if L_MFMA
    asm volatile("s_nop 1\n\tv_mfma_f32_32x32x64_f8f6f4 %0, %1, %2, %0 blgp:4" : "+v"(ol) : "v"(A8), "v"(ones));
#endif
#pragma unroll
    for (int d = 0; d < 4; ++d) asm volatile(PV8_NOP "v_mfma_f32_32x32x64_f8f6f4 %0, %1, %2, %0" : "+v"(o[d]) : "v"(A8), "v"(vf[d]));
}
template <int DUMMY = 0>
__device__ __forceinline__ void attn_core_diff8(const bf16* __restrict__ QKV, const unsigned char* __restrict__ V8Th, int mq0, int NT, int kcol, int kd0, float negb,
                                                const bf16x8 (&qr)[4], char* lds, f32x16 (&o)[4], f32x16& ol, float& l_reg, int tid) {
    asm volatile("" : "+v"(tid));
    i32x4a ones;
#pragma unroll
    for (int i = 0; i < 4; ++i) asm volatile("v_mov_b32 %0, 0x22222222" : "=v"(ones[i]));
    const int lane = tid & 63, r32 = lane & 31, hi = lane >> 5, wv = __builtin_amdgcn_readfirstlane(tid >> 6);
    const __amdgpu_buffer_rsrc_t rq = __builtin_amdgcn_make_buffer_rsrc((void*)QKV, 0, 0xffffffffu, 0x00020000);
    const __amdgpu_buffer_rsrc_t rv = __builtin_amdgcn_make_buffer_rsrc((void*)V8Th, 0, 0xffffffffu, 0x00020000);
    int rowK[2], colK[2];
#pragma unroll
    for (int i = 0; i < 2; ++i) { const int q = 2 * wv + i; rowK[i] = 4 * q + (lane >> 4); colK[i] = kcol + 8 * ((lane & 15) ^ (rowK[i] & 7)); }
    const int vcol = 16 * wv + (lane >> 2), voffV = vcol * 64 + 16 * ((lane & 3) ^ ((vcol >> 2) & 3));
    LAS unsigned char* ldsl = (LAS unsigned char*)(unsigned)(uintptr_t)lds;
    const int sw = (r32 >> 2) & 3;
    const LAS unsigned char* vr0 = ldsl + r32 * 64 + 16 * ((2 * hi) ^ sw); const LAS unsigned char* vr1 = ldsl + r32 * 64 + 16 * ((2 * hi + 1) ^ sw);
#define VOFFK(t, row, col) ((int)(((unsigned)(64 * (t) + (row)) * (unsigned)QKVW + (unsigned)(col)) * 2u))
#define DMA(t) do { const int sb_ = ((t) & 3) * SLOT8; \
        __builtin_amdgcn_raw_ptr_buffer_load_lds(rv, (LAS unsigned*)(ldsl + sb_ + wv * 1024), 16, voffV, (t) * 8192, 0, 0); \
        _Pragma("unroll") for (int i_ = 0; i_ < 2; ++i_) \
            __builtin_amdgcn_raw_ptr_buffer_load_lds(rq, (LAS unsigned*)(ldsl + sb_ + 8192 + (2 * wv + i_) * 1024), 16, VOFFK(t, rowK[i_], colK[i_]), 0, 0, 0); } while (0)
#define BAR() do { asm volatile("" ::: "memory"); __builtin_amdgcn_s_barrier(); asm volatile("" ::: "memory"); } while (0)
#define KS(t) (lds + ((t) & 3) * SLOT8 + 8192)
#define VB0(t) (vr0 + ((t) & 3) * SLOT8)
#define VB1(t) (vr1 + ((t) & 3) * SLOT8)
#define EXP16(P) do { _Pragma("unroll") for (int r_ = 0; r_ < 16; ++r_) P[r_] = __builtin_amdgcn_exp2f(P[r_]); } while (0)
    f32x16 pA0, pA1, pB0, pB1; i32x8a A8a, A8b = {0, 0, 0, 0, 0, 0, 0, 0};
#define KEEP(x) asm volatile("" :: "v"(x))
    DMA(0); DMA(1);
    asm volatile("s_waitcnt vmcnt(3)" ::: "memory"); BAR();
    if (2 < NT) DMA(2);
    qkt<4>(pA0, pA1, KS(0), qr, r32, hi, kd0, negb); EXP16(pA0);
    for (int j = 1; j + 1 < NT; j += 2) {
        asm volatile("s_waitcnt vmcnt(3)" ::: "memory"); BAR();
        DMA(j + 2);
        SBAR(); qkt<4>(pB0, pB1, KS(j), qr, r32, hi, kd0, negb);
        EXP16(pA1); finish_sm8(pA0, pA1, l_reg, A8a); KEEP(A8b); SBAR();
        pv8(o, ol, ones, VB0(j - 1), VB1(j - 1), A8a); EXP16(pB0);
        if (j + 3 < NT) { asm volatile("s_waitcnt vmcnt(3)" ::: "memory"); } else { asm volatile("s_waitcnt vmcnt(0)" ::: "memory"); }
        BAR();
        if (j + 3 < NT) DMA(j + 3);
        SBAR(); qkt<4>(pA0, pA1, KS(j + 1), qr, r32, hi, kd0, negb);
        EXP16(pB1); finish_sm8(pB0, pB1, l_reg, A8b); KEEP(A8a); SBAR();
        pv8(o, ol, ones, VB0(j), VB1(j), A8b); EXP16(pA0);
    }
    asm volatile("s_waitcnt vmcnt(0)" ::: "memory"); BAR();
    SBAR(); qkt<4>(pB0, pB1, KS(NT - 1), qr, r32, hi, kd0, negb);
    EXP16(pA1); finish_sm8(pA0, pA1, l_reg, A8a); KEEP(A8b); SBAR();
    pv8(o, ol, ones, VB0(NT - 2), VB1(NT - 2), A8a); EXP16(pB0);
    EXP16(pB1); finish_sm8(pB0, pB1, l_reg, A8b); KEEP(A8a); SBAR();
    pv8(o, ol, ones, VB0(NT - 1), VB1(NT - 1), A8b);
    asm volatile("s_nop 15\n\ts_nop 15" ::: "memory");
    __syncthreads();
#undef KEEP
#undef VOFFK
#undef DMA
#undef BAR
#undef KS
#undef VB0
#undef VB1
#undef EXP16
}

__device__ __forceinline__ void diff_unit(Frame& F, int h, int qb, float lam, float oscale, float negb, const float* __restrict__ og) {
    const bf16* QKV = (const bf16*)(F.ws + WS_QKV); bf16* AO = (bf16*)(F.ws + WS_AO);
    { unsigned z_; asm volatile("s_mov_b32 %0, 0" : "=s"(z_)); QKV += z_; AO += z_; }
    int lane = F.lane; asm volatile("" : "+v"(lane));
    const int r32 = lane & 31, hi = lane >> 5, map = F.wave >> 2, wq = F.wave & 3;
    const int mq0 = qb * 128 + wq * 32;
    bf16x8 qr[4];
    { const bf16* Qw = QKV + (size_t)(mq0 + r32) * QKVW + h * 128 + map * 64 + hi * 8;
#pragma unroll
      for (int d0 = 0; d0 < 4; ++d0) qr[d0] = *(const bf16x8*)(Qw + d0 * 16); }
    f32x16 o[4];
#pragma unroll
    for (int d = 0; d < 4; ++d)
#pragma unroll
        for (int r = 0; r < 16; ++r) o[d][r] = 0.f;
    float l_reg = 0.f;
    char* lds = (char*)F.lds;
#if DIFF_PV8
    f32x16 ol;
#pragma unroll
    for (int r = 0; r < 16; ++r) ol[r] = 0.f;
    attn_core_diff8<0>(QKV, (const unsigned char*)(F.ws + WS_V8T) + (size_t)h * 256 * 8192, mq0, S / 64, 1024 + h * 128, map * 64, negb, qr, lds, o, ol, l_reg, F.tid);
#else
    attn_core<4, false>(QKV, 1, 0, S, mq0, 0, S / 64, 1024 + h * 128, 2048 + h * 128, map * 64, negb, qr, lds, o, l_reg, F.tid);
#endif
    float* li_l = (float*)(lds + 65536) + F.wave * 64;
#if DIFF_PV8 && !L_MFMA
    { const auto rr = __builtin_amdgcn_permlane32_swap(__float_as_uint(l_reg), __float_as_uint(l_reg), false, false); l_reg = __uint_as_float(rr[0]) + __uint_as_float(rr[1]); }
#endif
#if !(DIFF_PV8 && L_MFMA)
    if (hi == 0) li_l[r32] = l_reg;
    LDS_WAIT();
#endif
    float* xch = (float*)lds;
#pragma unroll
    for (int r = 0; r < 16; ++r) {
#if DIFF_PV8 && L_MFMA
        const float rl = __builtin_amdgcn_rcpf(ol[r]);
#else
        const float rl = __builtin_amdgcn_rcpf(li_l[crow(r, hi)]);
#endif
#pragma unroll
        for (int d = 0; d < 4; ++d) o[d][r] *= rl; }
    if (map == 1) {
#pragma unroll
        for (int d = 0; d < 4; ++d)
#pragma unroll
            for (int r = 0; r < 16; ++r) xch[(d * 16 + r) * 256 + wq * 64 + lane] = o[d][r];
    }
    __syncthreads();
    if (map == 0) {
        float gv[4];
#pragma unroll
        for (int d = 0; d < 4; ++d) gv[d] = og[32 * d + r32] * oscale;
#pragma unroll
        for (int r = 0; r < 16; ++r) {
            float ss = 0.f;
#pragma unroll
            for (int d = 0; d < 4; ++d) { const float v = o[d][r] - lam * xch[(d * 16 + r) * 256 + wq * 64 + lane]; o[d][r] = v; ss += v * v; }
            ss += shflx(ss, 1, lane); ss += shflx(ss, 2, lane); ss += shflx(ss, 4, lane); ss += shflx(ss, 8, lane); ss += shflx(ss, 16, lane);
            const float rstd = 1.0f / sqrtf(ss * (1.f / 128.f) + EPS);
            bf16* orow = AO + (size_t)(mq0 + crow(r, hi)) * DM + h * 128 + r32;
#pragma unroll
            for (int d = 0; d < 4; ++d) orow[32 * d] = (bf16)f2bf(o[d][r] * rstd * gv[d]);
        }
    }
    __syncthreads();
}


#ifndef DIFF16
#define DIFF16 1
#endif
__device__ __forceinline__ int v16_gsw(int col) { return ((col >> 1) & 1) | (((col >> 3) & 1) ? 6 : 0); }
__device__ __forceinline__ void v8t16_phase(Frame& F) {
    const int gw = F.c * NWAVES + F.wave, NGW = F.G * NWAVES, lane = F.lane;
    const bf16* QKV = (const bf16*)(F.ws + WS_QKV); unsigned char* V8T = (unsigned char*)(F.ws + WS_V8T);
    unsigned char* scr = (unsigned char*)(F.lds + F.wave * 16384);
    for (int u = gw; u < 8 * 256; u += NGW) {
        const int h = u & 7, tile = u >> 3;
        const bf16* row = QKV + (size_t)(64 * tile + lane) * QKVW + 2048 + h * 128;
        u32x4 w[16];
#pragma unroll
        for (int j = 0; j < 16; ++j) w[j] = *(const u32x4*)(row + 8 * j);
#pragma unroll
        for (int j = 0; j < 16; ++j) { unsigned* d = (unsigned*)(scr + lane * 132 + 8 * j);
            d[0] = pg8::pk4_fp8(bflo(w[j].x), bfhi(w[j].x), bflo(w[j].y), bfhi(w[j].y)); d[1] = pg8::pk4_fp8(bflo(w[j].z), bfhi(w[j].z), bflo(w[j].w), bfhi(w[j].w)); }
        LDS_WAIT(); asm volatile("" ::: "memory");
        unsigned lo[16], hi2[16];
#pragma unroll
        for (int j = 0; j < 16; ++j) { unsigned a = 0, b = 0;
#pragma unroll
            for (int q = 0; q < 4; ++q) { const int key = 16 * (j & 3) + 4 * (j >> 2) + q;
                const unsigned short t = *(const unsigned short*)(scr + key * 132 + 2 * lane); a |= (unsigned)(t & 0xff) << (8 * q); b |= (unsigned)(t >> 8) << (8 * q); }
            lo[j] = a; hi2[j] = b; }
        unsigned char* dst = V8T + ((size_t)(h * 128 + (tile >> 1)) * 128 + 2 * lane) * 128 + 16 * (tile & 1);
#pragma unroll
        for (int q = 0; q < 4; ++q) { *(u32x4*)(dst + 32 * q) = (u32x4){lo[4 * q], lo[4 * q + 1], lo[4 * q + 2], lo[4 * q + 3]}; *(u32x4*)(dst + 128 + 32 * q) = (u32x4){hi2[4 * q], hi2[4 * q + 1], hi2[4 * q + 2], hi2[4 * q + 3]}; }
        LDS_WAIT(); asm volatile("" ::: "memory");
    }
}
constexpr int SLOT16 = 49152;
__device__ __forceinline__ void attn_core_diff16(const bf16* __restrict__ QKV, const unsigned char* __restrict__ V8Th, int NP, int kcol, int cmap, float negb,
                                                 const bf16x8 (&qr)[2][2], char* lds, f32x4 (&o)[2][8], f32x4 (&ol)[2], int tid) {
    asm volatile("" : "+v"(tid));
    const int lane = tid & 63, fr = lane & 15, fq = lane >> 4, wv = __builtin_amdgcn_readfirstlane(tid >> 6);
    const __amdgpu_buffer_rsrc_t rq = __builtin_amdgcn_make_buffer_rsrc((void*)QKV, 0, 0xffffffffu, 0x00020000);
    const __amdgpu_buffer_rsrc_t rv = __builtin_amdgcn_make_buffer_rsrc((void*)V8Th, 0, 0xffffffffu, 0x00020000);
    int rowK[2], colK[2], voffV[2], voffK[2];
#pragma unroll
    for (int i = 0; i < 2; ++i) { const int q = 2 * wv + i; rowK[i] = 4 * q + (lane >> 4); colK[i] = kcol + 8 * ((lane & 15) ^ (rowK[i] & 15));
        const int pc = q * 64 + lane, col = pc >> 3; voffV[i] = col * 128 + 16 * ((pc & 7) ^ v16_gsw(col)); voffK[i] = (rowK[i] * QKVW + colK[i]) * 2; }
    LAS unsigned char* ldsl = (LAS unsigned char*)(unsigned)(uintptr_t)lds;
    i32x4a ones;
#pragma unroll
    for (int i = 0; i < 4; ++i) asm volatile("v_mov_b32 %0, 0x22222222" : "=v"(ones[i]));
#define VOFFK(t, row, col) ((int)(((unsigned)(64 * (t) + (row)) * (unsigned)QKVW + (unsigned)(col)) * 2u))
#define DMA16(p) do { const int ks_ = ((p) & 1) * 32768, vs2_ = 65536 + (int)((unsigned)(p) % 3u) * 16384;        \
        _Pragma("unroll") for (int i_ = 0; i_ < 2; ++i_) { \
            __builtin_amdgcn_raw_ptr_buffer_load_lds(rv, (LAS unsigned*)(ldsl + vs2_ + (2 * wv + i_) * 1024), 16, voffV[i_], (p) * 16384, 0, 0); \
            __builtin_amdgcn_raw_ptr_buffer_load_lds(rq, (LAS unsigned*)(ldsl + ks_ + (2 * wv + i_) * 1024), 16, voffK[i_], (2 * (p)) * (64 * QKVW * 2), 0, 0);            \
            __builtin_amdgcn_raw_ptr_buffer_load_lds(rq, (LAS unsigned*)(ldsl + ks_ + 16384 + (2 * wv + i_) * 1024), 16, voffK[i_], (2 * (p) + 1) * (64 * QKVW * 2), 0, 0); } } while (0)
    const int kbase = fr * 256; const int kc0 = ((8 * cmap + fq) ^ fr) * 16, kc1 = ((8 * cmap + 4 + fq) ^ fr) * 16;
    const int vsw = ((fr >> 1) & 1);
    const int vg = vsw | ((fr >> 3) ? 6 : 0);
    const int vbase = fr * 128, vc0 = ((2 * fq) ^ vg) * 16, vc1 = ((2 * fq + 1) ^ vg) * 16;
    f32x4 sA[2][4], sB[2][4]; i32x8a AX[2], AY[2];
#define QK16(S, KSOFF) do { const LAS unsigned char* k0_ = ldsl + ((KSOFF) + kbase + kc0); const LAS unsigned char* k1_ = ldsl + ((KSOFF) + kbase + kc1);        \
        _Pragma("unroll") for (int kb = 0; kb < 4; ++kb) { \
            const bf16x8 a0 = *(const LAS bf16x8*)(k0_ + kb * 4096), a1 = *(const LAS bf16x8*)(k1_ + kb * 4096); \
            _Pragma("unroll") for (int qb = 0; qb < 2; ++qb) { S[qb][kb] = __builtin_amdgcn_mfma_f32_16x16x32_bf16(a0, qr[qb][0], (f32x4){negb, negb, negb, negb}, 0, 0, 0); \
                S[qb][kb] = __builtin_amdgcn_mfma_f32_16x16x32_bf16(a1, qr[qb][1], S[qb][kb], 0, 0, 0); } } } while (0)
#define EXPCH(S, T, KB, CUR) do { _Pragma("unroll") for (int qb = 0; qb < 2; ++qb) { _Pragma("unroll") for (int e = 0; e < 4; ++e) S[qb][KB][e] = __builtin_amdgcn_exp2f(S[qb][KB][e]); \
            CUR[qb][4 * (T) + (KB)] = pk4_fp8_inplace(S[qb][KB][0], S[qb][KB][1], S[qb][KB][2], S[qb][KB][3]); } } while (0)
#define LDV(VSB, CB) ({ const i32x4a x_ = *(const LAS i32x4a*)(v0p_ + (CB) * 2048), y_ = *(const LAS i32x4a*)(v1p_ + (CB) * 2048); \
            (i32x8a)__builtin_shufflevector(x_, y_, 0, 1, 2, 3, 4, 5, 6, 7); })
#define PVCB(PREV, VF, CB) do { _Pragma("unroll") for (int qb = 0; qb < 2; ++qb) asm volatile("v_mfma_f32_16x16x128_f8f6f4 %0, %1, %2, %0" : "+v"(o[qb][CB]) : "v"(PREV[qb]), "v"(VF)); } while (0)
#define ONES16(PREV) do { _Pragma("unroll") for (int qb = 0; qb < 2; ++qb) asm volatile("v_mfma_f32_16x16x128_f8f6f4 %0, %1, %2, %0 blgp:4" : "+v"(ol[qb]) : "v"(PREV[qb]), "v"(ones)); } while (0)
#define KOFF(p) (((p) & 1) * 32768)
#define VOFFS(p) (65536 + (int)((unsigned)(p) % 3u) * 16384)
#define GBAR() do { asm volatile("s_waitcnt vmcnt(0)" ::: "memory"); __builtin_amdgcn_s_barrier(); asm volatile("" ::: "memory"); } while (0)
#define ITER16(p, CUR, PREV) do { \
        GBAR();                                   \
        if ((p) + 1 < NP) DMA16((p) + 1); \
        { const int kb_ = KOFF(p); SBAR(); QK16(sA, kb_); QK16(sB, kb_ + 16384); SBAR(); } \
        { const int vs_ = VOFFS((p) - 1); const LAS unsigned char* v0p_ = ldsl + (vs_ + vbase + vc0); const LAS unsigned char* v1p_ = ldsl + (vs_ + vbase + vc1); i32x8a v0_ = LDV(vs_, 0), v1_; \
          ONES16(PREV); \
          v1_ = LDV(vs_, 1); PVCB(PREV, v0_, 0); EXPCH(sA, 0, 0, CUR); SBAR(); \
          v0_ = LDV(vs_, 2); PVCB(PREV, v1_, 1); EXPCH(sA, 0, 1, CUR); SBAR(); \
          v1_ = LDV(vs_, 3); PVCB(PREV, v0_, 2); EXPCH(sA, 0, 2, CUR); SBAR(); \
          v0_ = LDV(vs_, 4); PVCB(PREV, v1_, 3); EXPCH(sA, 0, 3, CUR); SBAR(); \
          v1_ = LDV(vs_, 5); PVCB(PREV, v0_, 4); EXPCH(sB, 1, 0, CUR); SBAR(); \
          v0_ = LDV(vs_, 6); PVCB(PREV, v1_, 5); EXPCH(sB, 1, 1, CUR); SBAR(); \
          v1_ = LDV(vs_, 7); PVCB(PREV, v0_, 6); EXPCH(sB, 1, 2, CUR); SBAR(); \
                             PVCB(PREV, v1_, 7); EXPCH(sB, 1, 3, CUR); SBAR(); } } while (0)
    DMA16(0);
    GBAR();
    if (1 < NP) DMA16(1);
    QK16(sA, KOFF(0)); QK16(sB, KOFF(0) + 16384);
    EXPCH(sA, 0, 0, AX); EXPCH(sA, 0, 1, AX); EXPCH(sA, 0, 2, AX); EXPCH(sA, 0, 3, AX); EXPCH(sB, 1, 0, AX); EXPCH(sB, 1, 1, AX); EXPCH(sB, 1, 2, AX); EXPCH(sB, 1, 3, AX);
    int p = 1;
    for (; p + 1 < NP; p += 2) { ITER16(p, AY, AX); ITER16(p + 1, AX, AY); }
    if (p < NP) { ITER16(p, AY, AX); }
    { const int vs_ = VOFFS(NP - 1); const LAS unsigned char* v0p_ = ldsl + (vs_ + vbase + vc0); const LAS unsigned char* v1p_ = ldsl + (vs_ + vbase + vc1);
      asm volatile("s_nop 1" ::: "memory");
      if ((NP & 1) == 0) { ONES16(AY);
#pragma unroll
          for (int cb = 0; cb < 8; ++cb) { const i32x8a vf = LDV(vs_, cb); PVCB(AY, vf, cb); } }
      else { ONES16(AX);
#pragma unroll
          for (int cb = 0; cb < 8; ++cb) { const i32x8a vf = LDV(vs_, cb); PVCB(AX, vf, cb); } } }
    asm volatile("s_nop 15\n\ts_nop 15" ::: "memory");
    __syncthreads();
#undef VOFFK
#undef DMA16
#undef QK16
#undef EXPCH
#undef LDV
#undef PVCB
#undef ONES16
#undef KOFF
#undef VOFFS
#undef GBAR
#undef ITER16
}
__device__ __forceinline__ void diff_unit16(Frame& F, int h, int qb_, float lam, float oscale, float negb, const float* __restrict__ og) {
    const bf16* QKV = (const bf16*)(F.ws + WS_QKV); bf16* AO = (bf16*)(F.ws + WS_AO);
    { unsigned z_; asm volatile("s_mov_b32 %0, 0" : "=s"(z_)); QKV += z_; AO += z_; }
    int lane = F.lane; asm volatile("" : "+v"(lane));
    const int fr = lane & 15, fq = lane >> 4, map = F.wave >> 2, wq = F.wave & 3;
    const int mq0 = qb_ * 128 + wq * 32;
    bf16x8 qr[2][2];
#pragma unroll
    for (int qb = 0; qb < 2; ++qb)
#pragma unroll
        for (int ks = 0; ks < 2; ++ks) qr[qb][ks] = *(const bf16x8*)(QKV + (size_t)(mq0 + 16 * qb + fr) * QKVW + h * 128 + map * 64 + 32 * ks + 8 * fq);
    f32x4 o[2][8], ol[2];
#pragma unroll
    for (int qb = 0; qb < 2; ++qb) { ol[qb] = (f32x4){0.f, 0.f, 0.f, 0.f};
#pragma unroll
        for (int cb = 0; cb < 8; ++cb) o[qb][cb] = (f32x4){0.f, 0.f, 0.f, 0.f}; }
    char* lds = (char*)F.lds;
    attn_core_diff16(QKV, (const unsigned char*)(F.ws + WS_V8T) + (size_t)h * 128 * 16384, S / 128, 1024 + h * 128, map, negb, qr, lds, o, ol, F.tid);
    float* xch = (float*)lds;
#pragma unroll
    for (int qb = 0; qb < 2; ++qb)
#pragma unroll
        for (int e = 0; e < 4; ++e) { const float rl = __builtin_amdgcn_rcpf(ol[qb][e]);
#pragma unroll
            for (int cb = 0; cb < 8; ++cb) o[qb][cb][e] *= rl; }
    if (map == 1) {
#pragma unroll
        for (int qb = 0; qb < 2; ++qb)
#pragma unroll
            for (int cb = 0; cb < 8; ++cb)
#pragma unroll
                for (int e = 0; e < 4; ++e) xch[((qb * 8 + cb) * 4 + e) * 256 + wq * 64 + lane] = o[qb][cb][e];
    }
    __syncthreads();
    if (map == 0) {
        float gv[8];
#pragma unroll
        for (int cb = 0; cb < 8; ++cb) gv[cb] = og[16 * cb + fr] * oscale;
#pragma unroll
        for (int qb = 0; qb < 2; ++qb)
#pragma unroll
            for (int e = 0; e < 4; ++e) {
                float ss = 0.f;
#pragma unroll
                for (int cb = 0; cb < 8; ++cb) { const float v = o[qb][cb][e] - lam * xch[((qb * 8 + cb) * 4 + e) * 256 + wq * 64 + lane]; o[qb][cb][e] = v; ss += v * v; }
                ss += shflx(ss, 1, lane); ss += shflx(ss, 2, lane); ss += shflx(ss, 4, lane); ss += shflx(ss, 8, lane);
                const float rstd = 1.0f / sqrtf(ss * (1.f / 128.f) + EPS);
                bf16* orow = AO + (size_t)(mq0 + 16 * qb + 4 * fq + e) * DM + h * 128 + fr;
#pragma unroll
                for (int cb = 0; cb < 8; ++cb) orow[16 * cb] = (bf16)f2bf(o[qb][cb][e] * rstd * gv[cb]);
            }
    }
    __syncthreads();
}

__device__ __forceinline__ void dil_unit(Frame& F, int b, int dil, int h, int res, int mblk, float negb) {
    const bf16* QKV = (const bf16*)(F.ws + WS_QKV);
    { unsigned z_; asm volatile("s_mov_b32 %0, 0" : "=s"(z_)); QKV += z_; }
    bf16* OP = (bf16*)(F.ws + WS_DILP) + (size_t)b * S * 1024; float* LP = (float*)(F.ws + WS_DILL) + (size_t)b * S * 8;
    int lane = F.lane; asm volatile("" : "+v"(lane));
    const int r32 = lane & 31, hi = lane >> 5;
    const int L = S / dil, m0 = mblk * 256, mq0 = m0 + 32 * F.wave;
    bf16x8 qr[8];
    { const bf16* Qw = QKV + ((size_t)(mq0 + r32) * dil + res) * QKVW + 3072 + h * 128 + hi * 8;
#pragma unroll
      for (int d0 = 0; d0 < 8; ++d0) qr[d0] = *(const bf16x8*)(Qw + d0 * 16); }
    f32x16 o[4];
#pragma unroll
    for (int d = 0; d < 4; ++d)
#pragma unroll
        for (int r = 0; r < 16; ++r) o[d][r] = 0.f;
    float l_reg = 0.f;
    attn_core<8, true>(QKV, dil, res, L, mq0, m0 - 64, 6, 4096 + h * 128, 5120 + h * 128, 0, negb, qr, (char*)F.lds, o, l_reg, F.tid);
    if (hi == 0) LP[((size_t)(mq0 + r32) * dil + res) * 8 + h] = l_reg;
#pragma unroll
    for (int r = 0; r < 16; ++r) { bf16* orow = OP + ((size_t)(mq0 + crow(r, hi)) * dil + res) * 1024 + h * 128 + r32;
#pragma unroll
        for (int d = 0; d < 4; ++d) orow[32 * d] = (bf16)f2bf(o[d][r]); }
}

__device__ __forceinline__ float vec_absmax(const float* g, int n, int lane) {
    float m = 0.f; for (int i = lane; i < n; i += 64) m = fmaxf(m, fabsf(g[i]));
#pragma unroll
    for (int o = 1; o < 64; o <<= 1) m = fmaxf(m, shflx(m, o, lane));
    return m;
}
#ifndef PHASE_SPLIT
#define PHASE_SPLIT 1
#endif
__device__ __forceinline__ void dil_units_phase(Frame& F) {
    const float negbB = 0.f;
#ifndef DIL_REP
#define DIL_REP 1
#endif
    for (int rep_ = 0; rep_ < DIL_REP; ++rep_)
    for (int u = F.c; u < 3 * 512; u += F.G) {
        const int b = u >> 9, idx = u & 511, h = idx & 7, rest = idx >> 3, dil = b == 0 ? 1 : (b == 1 ? 4 : 16), nb = 64 / dil;
        dil_unit(F, b, dil, h, rest / nb, rest % nb, negbB);
    }
}
__device__ __forceinline__ void attention_phase(Frame& F, int l) {
    const float* const* P = F.in + 1 + 17 * l;
    float a = 0.f, b = 0.f; { const int i = F.lane; a = P[4][i] * P[5][i]; b = P[6][i] * P[7][i]; }
    a = wave_sum(a, F.lane); b = wave_sum(b, F.lane);
    const float lam_init = l == 0 ? 0.2f : 0.35550906759096934f;
    const float lam = __builtin_bit_cast(float, __builtin_amdgcn_readfirstlane(__builtin_bit_cast(int, __expf(a) - __expf(b) + lam_init)));
#if DIFF_PV8
    const float negbA = __builtin_bit_cast(float, __builtin_amdgcn_readfirstlane(__builtin_bit_cast(int, 8.8f - (8.0f * LOG2E * 1.02f) * vec_absmax(P[2], 64, F.lane) * vec_absmax(P[3], 64, F.lane))));
#else
    const float negbA = 0.f;
#endif
#if DIFF16
    for (int u = F.c; u < 8 * 128; u += F.G) diff_unit16(F, u & 7, u >> 3, lam, 1.0f - lam_init, negbA, P[8]);
#else
    for (int u = F.c; u < 8 * 128; u += F.G) diff_unit(F, u & 7, u >> 3, lam, 1.0f - lam_init, negbA, P[8]);
#endif
#if !PHASE_SPLIT
    dil_units_phase(F);
#endif
}
#ifndef PHASE_MASK
#define PHASE_MASK 0x7ff
#endif
#define PH_ON(k) ((PHASE_MASK >> (k)) & 1)
#ifndef DUP_MASK
#define DUP_MASK 0
#endif
#ifndef DUP_LAYERS
#define DUP_LAYERS 3
#endif
#define DUP(k, l) ((((DUP_MASK) >> (k)) & 1) && (((DUP_LAYERS) >> (l)) & 1))
constexpr int N_PHASES = 21;
struct Args { const float* in[36]; float* out; unsigned char* ws; int ph_lo, ph_hi; };
__global__ void __launch_bounds__(NTHR, 2) fwd_kernel(Args args) {
    extern __shared__ __attribute__((aligned(16))) unsigned char lds[];
    Frame F;
    const int wave_s = __builtin_amdgcn_readfirstlane(threadIdx.x >> 6);
#define LANE_NOW() ({ int l_; asm volatile("v_mbcnt_lo_u32_b32 %0, -1, 0\n\tv_mbcnt_hi_u32_b32 %0, -1, %0" : "=v"(l_)); l_; })
    F.lds = lds; F.tid = wave_s * 64 + LANE_NOW(); F.lane = F.tid & 63; F.wave = wave_s;
    F.G = gridDim.x; F.c = blockIdx.x; F.in = args.in; F.out = args.out; F.ws = args.ws;
    unsigned char* ws = args.ws;
    volatile LAS unsigned* MISC = (volatile LAS unsigned*)((LAS unsigned char*)lds + MISC_OFF);
    if (F.tid < 64) MISC[F.tid] = 0u;
    __syncthreads();
#if MK_PER_PHASE
#define GRID_BAR() do { } while (0)
#else
    XcdBarrier bar = xcd_barrier_post((unsigned*)(ws + WS_CTL) + CW_BAR, MISC + 8, F.tid == 0);
#define GRID_BAR() do { unsigned zb_; asm volatile("s_mov_b32 %0, 0" : "=s"(zb_)); XcdBarrier b2_ = bar; b2_.bar += zb_; b2_.x = xb_xcc_id();     \
        xcd_barrier(b2_, (wave_s * 64 + LANE_NOW()) == 0); } while (0)
#endif
#if MK_PER_PHASE
    const int lo = args.ph_lo, hi = args.ph_hi;
#else
    constexpr int lo = 0, hi = N_PHASES;
#endif
#define IN(k) (lo <= (k) && (k) < hi)
#define FRESH() do { unsigned z_; asm volatile("s_mov_b32 %0, 0" : "=s"(z_)); ws = args.ws + z_; F.ws = ws; F.out = args.out + z_; int t_ = wave_s * 64 + LANE_NOW(); asm volatile("" : "+v"(t_)); F.tid = t_; F.lane = t_ & 63; F.wave = wave_s; } while (0)
#define SEAM(k) do { if (IN(k) && IN((k) + 1)) GRID_BAR(); } while (0)
    PG8_LAS unsigned char* glds = (PG8_LAS unsigned char*)lds;

    if (IN(0) && PH_ON(10)) { FRESH(); p0_prologue(F); if (DUP(10, 0)) { GRID_BAR(); FRESH(); p0_prologue(F); } } SEAM(0);

    for (int l = 0; l < 2; ++l) {
        const int pb = 1 + 10 * l;
        if (IN(pb + 0) && PH_ON(0)) for (int rep = 0; rep < (DUP(0, l) ? 2 : 1); ++rep) { if (rep) GRID_BAR(); FRESH();
            pg8::Gemm g{(const bf16*)(ws + WS_H), (const bf16*)(ws + WS_WIN) + (size_t)l * QKVW * DM, S, QKVW, DM}; pg8::StaticOrder So; So.init(S, QKVW, F.G, F.c);
            const float* cA_ = (const float*)(ws + WS_ROPE); const float* sA_ = cA_ + (size_t)S * 32; const float* cB_ = sA_ + (size_t)S * 32; const float* sB_ = cB_ + (size_t)S * 64;
            pg8::EpiQKV E{(bf16*)(ws + WS_QKV), QKVW, cA_, sA_, cB_, sB_, F.in[1 + 17 * l + 2], F.in[1 + 17 * l + 3], F.in[1 + 17 * l + 9], F.in[1 + 17 * l + 10],
                          (PG8_LAS float*)(glds + MISC_OFF + 1024), EPS, 0.125f * LOG2E, 0.08838834764831845f * LOG2E};
            pg8::gemm_phase<pg8::EpiQKV, pg8::StaticOrder, false>(glds, g, So, E, nullptr, F.tid);
        } SEAM(pb + 0);
#if DIFF_PV8
        if (IN(pb + 1) && PH_ON(1)) { FRESH(); if (DIFF16) v8t16_phase(F); else v8t_phase(F); if (PHASE_SPLIT) { __syncthreads(); dil_units_phase(F); } } SEAM(pb + 1);
#endif
        if (IN(pb + 2) && PH_ON(2)) for (int rep = 0; rep < (DUP(2, l) ? 2 : 1); ++rep) { if (rep) GRID_BAR(); FRESH(); attention_phase(F, l); if (PHASE_SPLIT) dil_combine_phase(F, l); } if (!PHASE_SPLIT) SEAM(pb + 2);
        if (IN(pb + 3) && PH_ON(3)) for (int rep = 0; rep < (DUP(3, l) ? 2 : 1); ++rep) { if (rep) GRID_BAR(); FRESH(); if (!PHASE_SPLIT || rep) dil_combine_phase(F, l); } SEAM(pb + 3);
        if (IN(pb + 4) && PH_ON(4)) for (int rep = 0; rep < (DUP(4, l) ? 2 : 1); ++rep) { if (rep) GRID_BAR(); FRESH();
            pg8::Gemm g{(const bf16*)(ws + WS_AO), (const bf16*)(ws + WS_WOUT) + (size_t)l * DM * DM, S, DM, DM}; pg8::StaticOrder So; So.init(S, DM, F.G, F.c);
            bf16* xrb = (bf16*)(ws + WS_XRB);
            if (l == 0) { pg8::EpiResB<true, false> E{xrb, (const void*)F.in[0], DM, 1.0f}; pg8::gemm_phase<pg8::EpiResB<true, false>, pg8::StaticOrder, false>(glds, g, So, E, nullptr, F.tid); }
            else { pg8::EpiResB<false, false> E{xrb, (const void*)xrb, DM, 1.0f}; pg8::gemm_phase<pg8::EpiResB<false, false>, pg8::StaticOrder, false>(glds, g, So, E, nullptr, F.tid); }
        } SEAM(pb + 4);
        if (IN(pb + 5) && PH_ON(5)) for (int rep = 0; rep < (DUP(5, l) ? 2 : 1); ++rep) { if (rep) GRID_BAR(); FRESH();
#if GU_FP6
            if (l == 0) norm6_phase<true>(F, (const void*)(ws + WS_XRB), F.in[14], (unsigned char*)(ws + WS_H));
            else norm_router6_phase(F, (const bf16*)(ws + WS_XRB), F.in[31], (unsigned char*)(ws + WS_H), F.in[32]);
#else
            if (l == 0) norm_phase<DENSE_GU_FP8 != 0, true>(F, (const void*)(ws + WS_XRB), F.in[14], (bf16*)(ws + WS_H));
            else norm_router_phase(F, (const bf16*)(ws + WS_XRB), F.in[31], (bf16*)(ws + WS_H), F.in[32]);
#endif
        } SEAM(pb + 5);
        if (IN(pb + 6) && PH_ON(6)) for (int rep = 0; rep < (DUP(6, l) ? 2 : 1); ++rep) { if (rep) GRID_BAR(); FRESH(); if (l == 1) moe_scatter_phase(F); } if (l == 1) SEAM(pb + 6);
        if (IN(pb + 7) && PH_ON(7)) for (int rep = 0; rep < (DUP(7, l) ? 2 : 1); ++rep) { if (rep) GRID_BAR(); FRESH();
            if (l == 0) {
#if DENSE_GU_FP8
                pg8::Gemm g{(const bf16*)(ws + WS_H), (const bf16*)(ws + WS_WGU), S, 2 * DFF, DM / 2}; pg8::StaticOrder So; So.init(S, 2 * DFF, F.G, F.c);
#if DENSE_DN_FP8
                pg8::EpiSwiGLU8<GU_FP6 == 0> E{(unsigned char*)(ws + WS_HID), DFF, 1 << 20, GU_FP6 ? 1.0f : W8INV};
                pg8::gemm_phase<pg8::EpiSwiGLU8<GU_FP6 == 0>, pg8::StaticOrder, false, true, GU_FP6 != 0>(glds, g, So, E, nullptr, F.tid);
#else
#error "fp8 gate/up with a bf16 down GEMM is not wired up"
#endif
#else
                pg8::Gemm g{(const bf16*)(ws + WS_H), (const bf16*)(ws + WS_WGU), S, 2 * DFF, DM}; pg8::StaticOrder So; So.init(S, 2 * DFF, F.G, F.c);
#if DENSE_DN_FP8
                pg8::EpiSwiGLU8<GU_FP6 == 0> E{(unsigned char*)(ws + WS_HID), DFF, 1 << 20, 1.0f};
                pg8::gemm_phase<pg8::EpiSwiGLU8<GU_FP6 == 0>, pg8::StaticOrder, false>(glds, g, So, E, nullptr, F.tid);
#else
                pg8::EpiSwiGLU E{(bf16*)(ws + WS_HID), DFF, 1 << 20};
                pg8::gemm_phase<pg8::EpiSwiGLU, pg8::StaticOrder, false>(glds, g, So, E, nullptr, F.tid);
#endif
#endif
            } else {
                const int* meta = (const int*)(ws + WS_TOK + TK_META);
                pg8::Gemm g{(const bf16*)(ws + WS_XG), (const bf16*)(ws + WS_MGU), MPAD_MAX, NE * 2 * DEXP, DM / 2}; pg8::MoeOrder Mo; Mo.init(meta, 2 * DEXP / 256, F.G, F.c);
                pg8::EpiSwiGLU8<GU_FP6 == 0> E{(unsigned char*)(ws + WS_HID), DEXP, 2 * DEXP / 256, GU_FP6 ? 1.0f : W8INV};
                pg8::gemm_phase<pg8::EpiSwiGLU8<GU_FP6 == 0>, pg8::MoeOrder, false, true, GU_FP6 != 0>(glds, g, Mo, E, nullptr, F.tid);
            }
        } SEAM(pb + 7);
        if (IN(pb + 8) && PH_ON(8)) for (int rep = 0; rep < (DUP(8, l) ? 2 : 1); ++rep) { if (rep) GRID_BAR(); FRESH();
            if (l == 0) {
#if DENSE_DN_FP8
                pg8::Gemm g{(const bf16*)(ws + WS_HID), (const bf16*)(ws + WS_WDN), S, DM, DFF / 2}; pg8::StaticOrder So; So.init(S, DM, F.G, F.c);
                pg8::EpiResB<false, true> E{(bf16*)(ws + WS_XRB), (const void*)(ws + WS_XRB), DM, W8INV};
                pg8::gemm_phase<pg8::EpiResB<false, true>, pg8::StaticOrder, false, true>(glds, g, So, E, nullptr, F.tid);
#else
                pg8::Gemm g{(const bf16*)(ws + WS_HID), (const bf16*)(ws + WS_WDN), S, DM, DFF}; pg8::StaticOrder So; So.init(S, DM, F.G, F.c);
                pg8::EpiResB<false, false> E{(bf16*)(ws + WS_XRB), (const void*)(ws + WS_XRB), DM, 1.0f};
                pg8::gemm_phase<pg8::EpiResB<false, false>, pg8::StaticOrder, false>(glds, g, So, E, nullptr, F.tid);
#endif
            } else {
                const int* meta = (const int*)(ws + WS_TOK + TK_META);
                pg8::Gemm g{(const bf16*)(ws + WS_HID), (const bf16*)(ws + WS_MDN), MPAD_MAX, NE * DM, DEXP / 2}; pg8::MoeOrder Mo; Mo.init(meta, DM / 256, F.G, F.c);
                pg8::EpiBf16 E{(bf16*)(ws + WS_YE), DM, DM / 256};
                pg8::gemm_phase<pg8::EpiBf16, pg8::MoeOrder, false, true>(glds, g, Mo, E, nullptr, F.tid);
            }
        } SEAM(pb + 8);
        if (IN(pb + 9) && PH_ON(9)) for (int rep = 0; rep < (DUP(9, l) ? 2 : 1); ++rep) { if (rep) GRID_BAR(); FRESH();
            if (l == 0) norm_phase<false, true>(F, (const void*)(ws + WS_XRB), F.in[18], (bf16*)(ws + WS_H));
            else moe_combine_phase(F);
        } SEAM(pb + 9);
    }
#undef IN
#undef SEAM
}

extern "C" void kernel_launch(void* const* d_in, const int* in_sizes, int n_in, void* d_out, int out_size, void* d_ws, size_t ws_size, hipStream_t stream) {
    static int grid = 0;
    if (grid == 0) {
        if (n_in != 36 || in_sizes[0] != S * DM || out_size != S * DM || ws_size < WS_END) {
            fprintf(stderr, "kernel_launch: shape mismatch: n_in %d in0 %d out %d ws %zu (need >= %zu)\n", n_in, n_in > 0 ? in_sizes[0] : -1, out_size, ws_size, (size_t)WS_END); grid = -1; return; }
        int dev = 0, cus = 0, per_cu = 0;
        if (hipGetDevice(&dev) != hipSuccess || hipDeviceGetAttribute(&cus, hipDeviceAttributeMultiprocessorCount, dev) != hipSuccess) { fprintf(stderr, "kernel_launch: device query failed\n"); grid = -1; return; }
        if (hipFuncSetAttribute((const void*)fwd_kernel, hipFuncAttributeMaxDynamicSharedMemorySize, LDS_BYTES) != hipSuccess) { fprintf(stderr, "kernel_launch: hipFuncSetAttribute failed\n"); grid = -1; return; }
        if (hipOccupancyMaxActiveBlocksPerMultiprocessor(&per_cu, (const void*)fwd_kernel, NTHR, LDS_BYTES) != hipSuccess || per_cu < 1)
            fprintf(stderr, "kernel_launch: note: occupancy query reports %d workgroups per CU\n", per_cu);
        (void)hipGetLastError();
        grid = cus;
        if (grid != 256) { fprintf(stderr, "kernel_launch: this kernel needs a 256-CU device (got %d)\n", cus); grid = -1; return; }
    }
    if (grid < 0) return;
    if (hipMemsetAsync((char*)d_ws + WS_CTL, 0, CTL_ZERO_BYTES, stream) != hipSuccess) { fprintf(stderr, "kernel_launch: memset failed\n"); return; }
    Args a{};
    for (int i = 0; i < 36; ++i) a.in[i] = (const float*)d_in[i];
    a.out = (float*)d_out; a.ws = (unsigned char*)d_ws;
#if MK_PER_PHASE
    for (int p = 0; p < N_PHASES; ++p) {
        if (p == 7) continue;
        a.ph_lo = p; a.ph_hi = p + 1;
        hipLaunchKernelGGL(fwd_kernel, dim3(grid), dim3(NTHR), LDS_BYTES, stream, a);
    }
#else
    a.ph_lo = 0; a.ph_hi = N_PHASES;
    hipLaunchKernelGGL(fwd_kernel, dim3(grid), dim3(NTHR), LDS_BYTES, stream, a);
#endif
    const hipError_t le = hipPeekAtLastError();
    if (le != hipSuccess) fprintf(stderr, "kernel_launch: launch failed: %s\n", hipGetErrorName(le));
}
```
